# Optimizing an MI355X kernel written in HIP

```python
import math
import jax, jax.numpy as jnp
from jax import lax
import numpy as np

D_MODEL = 2048
BATCH = 8
SEQ = 4096
DEPTH = 4

ATTN_HEADS = 8
QK_DIM = 64
V_DIM = 2 * QK_DIM
QK_WIDTH = ATTN_HEADS * 2 * QK_DIM
ATTN_WIDTH = ATTN_HEADS * V_DIM
Q_BLOCK = 128
ROPE_THETA = 10000.0
LRU_WIDTH = D_MODEL - ATTN_WIDTH
LRU_BLOCKS = 8
LRU_BLOCK = LRU_WIDTH // LRU_BLOCKS
LRU_CONV = 4
LRU_C = 8.0
D_FF = 3 * D_MODEL
FFN_CONV = 3
IN_WIDTH = 2 * QK_WIDTH + ATTN_WIDTH + 2 * LRU_WIDTH
EPS = 1e-6

kernel_name = "hymba_diffattn_rglru_convffn_trunk"


def lambda_init_fn(layer_idx):
    return 0.8 - 0.6 * math.exp(-0.3 * layer_idx)


def rmsnorm(x, gain):
    x32 = x.astype(jnp.float32)
    y = x32 * lax.rsqrt(jnp.mean(x32 * x32, axis=-1, keepdims=True) + EPS)
    return (y * gain.astype(jnp.float32)).astype(x.dtype)


def causal_dwconv(x, w, b):
    K = w.shape[0]
    S = x.shape[1]
    xp = jnp.pad(x, ((0, 0), (K - 1, 0), (0, 0)))
    y = b + xp[:, 0:S] * w[0]
    for j in range(1, K):
        y = y + xp[:, j:j + S] * w[j]
    return y


def rope_tables(positions):
    inv_freq = 1.0 / (ROPE_THETA ** (jnp.arange(0, QK_DIM, 2, dtype=jnp.float32) / QK_DIM))
    ang = positions.astype(jnp.float32)[..., None] * inv_freq
    return jnp.cos(ang), jnp.sin(ang)


def apply_rope(t, cos, sin):
    t32 = t.astype(jnp.float32)
    c = cos[:, :, None, None, :]
    s = sin[:, :, None, None, :]
    t1, t2 = jnp.split(t32, 2, axis=-1)
    return jnp.concatenate([t1 * c - t2 * s, t2 * c + t1 * s], axis=-1).astype(t.dtype)


def diff_attention(q, k, v, lam, subln_g, lambda_init):
    B, S = q.shape[0], q.shape[1]
    qh = q.transpose(0, 2, 3, 1, 4)
    kh = k.transpose(0, 2, 3, 1, 4)
    vh = v.transpose(0, 2, 1, 3)
    scale = QK_DIM ** -0.5
    outs = []
    for qb in range(S // Q_BLOCK):
        qs, qe = qb * Q_BLOCK, (qb + 1) * Q_BLOCK
        s = jnp.einsum('bhcqd,bhckd->bhcqk', qh[:, :, :, qs:qe], kh[:, :, :, :qe]).astype(jnp.float32) * scale
        mask = jnp.arange(qs, qe)[:, None] >= jnp.arange(qe)[None, :]
        s = jnp.where(mask, s, -jnp.inf)
        p = jax.nn.softmax(s, axis=-1)
        a = p[:, :, 0] - lam * p[:, :, 1]
        outs.append(jnp.einsum('bhqk,bhkd->bhqd', a, vh[:, :, :qe].astype(jnp.float32)))
    o = jnp.concatenate(outs, axis=2)
    o = rmsnorm(o, subln_g) * (1.0 - lambda_init)
    return o.transpose(0, 2, 1, 3).reshape(B, S, ATTN_WIDTH).astype(v.dtype)


def rglru_branch(xb, gb, conv_w, conv_b, ga_w, ga_b, gx_w, gx_b, lru_lambda, lru_norm):
    B, S = xb.shape[0], xb.shape[1]
    xc = causal_dwconv(xb, conv_w, conv_b)
    xh = xc.reshape(B, S, LRU_BLOCKS, LRU_BLOCK)
    r = jax.nn.sigmoid(jnp.einsum('bshi,hij->bshj', xh, ga_w) + ga_b).reshape(B, S, LRU_WIDTH)
    i = jax.nn.sigmoid(jnp.einsum('bshi,hij->bshj', xh, gx_w) + gx_b).reshape(B, S, LRU_WIDTH)
    r32 = r.astype(jnp.float32)
    log_a = -LRU_C * r32 * jax.nn.softplus(-lru_lambda.astype(jnp.float32))
    a = jnp.exp(log_a)
    mult = jnp.sqrt(-jnp.expm1(2.0 * log_a))
    bterm = mult * (i.astype(jnp.float32) * xc.astype(jnp.float32))

    def combine(left, right):
        a1, b1 = left
        a2, b2 = right
        return a1 * a2, a2 * b1 + b2

    _, h = lax.associative_scan(combine, (a, bterm), axis=1)
    y = h.astype(xb.dtype) * jax.nn.gelu(gb)
    return rmsnorm(y, lru_norm)


def conv_glu_mlp(h, w_up, cw, cb, w_down):
    u = causal_dwconv(h @ w_up, cw, cb)
    g, val = jnp.split(u, 2, axis=-1)
    return (jax.nn.gelu(g) * val) @ w_down


def setup_inputs(seed: int = 0) -> dict:
    key = jax.random.key(seed)
    ks = jax.random.split(key, 24)
    f32 = jnp.float32
    n = lambda k, shp, s: jax.random.normal(k, shp, f32) * s
    x = jax.random.normal(ks[0], (BATCH, SEQ, D_MODEL), f32)
    offs = jax.random.randint(ks[1], (BATCH, 1), 0, 1024, dtype=jnp.int32)
    positions = (offs + jnp.arange(SEQ, dtype=jnp.int32)[None, :]).astype(jnp.int32)
    u = jax.random.uniform(ks[2], (DEPTH, LRU_WIDTH), f32, minval=0.9, maxval=0.999)
    a0 = u ** (1.0 / LRU_C)
    lru_lambda = jnp.log(a0) - jnp.log1p(-a0)
    return {
        "x": x,
        "positions": positions,
        "attn_norm": 1.0 + n(ks[3], (DEPTH, D_MODEL), 0.02),
        "w_in": n(ks[4], (DEPTH, D_MODEL, IN_WIDTH), D_MODEL ** -0.5),
        "lambda_q1": n(ks[5], (DEPTH, QK_DIM), 0.1),
        "lambda_k1": n(ks[6], (DEPTH, QK_DIM), 0.1),
        "lambda_q2": n(ks[7], (DEPTH, QK_DIM), 0.1),
        "lambda_k2": n(ks[8], (DEPTH, QK_DIM), 0.1),
        "subln": 1.0 + n(ks[9], (DEPTH, V_DIM), 0.02),
        "lru_conv_w": n(ks[10], (DEPTH, LRU_CONV, LRU_WIDTH), LRU_CONV ** -0.5),
        "lru_conv_b": n(ks[11], (DEPTH, LRU_WIDTH), 0.01),
        "gate_a_w": n(ks[12], (DEPTH, LRU_BLOCKS, LRU_BLOCK, LRU_BLOCK), LRU_BLOCK ** -0.5),
        "gate_a_b": n(ks[13], (DEPTH, LRU_BLOCKS, LRU_BLOCK), 0.01),
        "gate_x_w": n(ks[14], (DEPTH, LRU_BLOCKS, LRU_BLOCK, LRU_BLOCK), LRU_BLOCK ** -0.5),
        "gate_x_b": n(ks[15], (DEPTH, LRU_BLOCKS, LRU_BLOCK), 0.01),
        "lru_lambda": lru_lambda,
        "lru_norm": 1.0 + n(ks[16], (DEPTH, LRU_WIDTH), 0.02),
        "w_out": n(ks[17], (DEPTH, D_MODEL, D_MODEL), D_MODEL ** -0.5),
        "mlp_norm": 1.0 + n(ks[18], (DEPTH, D_MODEL), 0.02),
        "w_up": n(ks[19], (DEPTH, D_MODEL, 2 * D_FF), D_MODEL ** -0.5),
        "ffn_conv_w": n(ks[20], (DEPTH, FFN_CONV, 2 * D_FF), FFN_CONV ** -0.5),
        "ffn_conv_b": n(ks[21], (DEPTH, 2 * D_FF), 0.01),
        "w_down": n(ks[22], (DEPTH, D_FF, D_MODEL), D_FF ** -0.5),
        "final_norm": 1.0 + n(ks[23], (D_MODEL,), 0.02),
    }


def reference(x, positions, attn_norm, w_in, lambda_q1, lambda_k1, lambda_q2, lambda_k2,
              subln, lru_conv_w, lru_conv_b, gate_a_w, gate_a_b, gate_x_w, gate_x_b,
              lru_lambda, lru_norm, w_out, mlp_norm, w_up, ffn_conv_w, ffn_conv_b,
              w_down, final_norm):
    B, S = x.shape[0], x.shape[1]
    cos, sin = rope_tables(positions)
    splits = [QK_WIDTH, 2 * QK_WIDTH, 2 * QK_WIDTH + ATTN_WIDTH, 2 * QK_WIDTH + ATTN_WIDTH + LRU_WIDTH]
    for l in range(DEPTH):
        lam_init = lambda_init_fn(l)
        h = rmsnorm(x, attn_norm[l])
        proj = h @ w_in[l]
        q, k, v, xb, gb = jnp.split(proj, splits, axis=-1)
        q = apply_rope(q.reshape(B, S, ATTN_HEADS, 2, QK_DIM), cos, sin)
        k = apply_rope(k.reshape(B, S, ATTN_HEADS, 2, QK_DIM), cos, sin)
        v = v.reshape(B, S, ATTN_HEADS, V_DIM)
        lam = (jnp.exp(jnp.sum(lambda_q1[l].astype(jnp.float32) * lambda_k1[l].astype(jnp.float32)))
               - jnp.exp(jnp.sum(lambda_q2[l].astype(jnp.float32) * lambda_k2[l].astype(jnp.float32)))
               + lam_init)
        attn_out = diff_attention(q, k, v, lam, subln[l], lam_init)
        lru_out = rglru_branch(xb, gb, lru_conv_w[l], lru_conv_b[l], gate_a_w[l], gate_a_b[l],
                               gate_x_w[l], gate_x_b[l], lru_lambda[l], lru_norm[l])
        mixed = jnp.concatenate([attn_out.astype(x.dtype), lru_out.astype(x.dtype)], axis=-1)
        x = x + mixed @ w_out[l]
        h = rmsnorm(x, mlp_norm[l])
        x = x + conv_glu_mlp(h, w_up[l], ffn_conv_w[l], ffn_conv_b[l], w_down[l])
    return rmsnorm(x, final_norm)
```

```cpp
#include <hip/hip_runtime.h>
#include <cstdio>
#include <cstdint>
namespace pg8 {
#define PG8_LAS __attribute__((address_space(3)))
typedef unsigned short bf16_t;
typedef short bf16x8 __attribute__((ext_vector_type(8)));
typedef float f32x4 __attribute__((ext_vector_type(4)));
typedef unsigned u32x4 __attribute__((ext_vector_type(4)));
constexpr int BM = 256, BK = 64, HALF = 128, HTB = HALF * BK * 2  , STAGE_BYTES = 8 * HTB, NXCD = 8, WGM = 8;

__host__ __device__ __forceinline__ int lds_byte(int r, int c) { const int st = (r >> 4) * 2 + (c >> 5), rr = r & 15, cc = c & 31, ob = rr * 64 + cc * 2; return st * 1024 + (ob ^ (((ob >> 9) & 1) << 5)); }
__host__ __device__ __forceinline__ void stage_rc(int b, int& R, int& C) { const int st = b / 1024, sb = b % 1024, swz = sb ^ (((sb >> 9) & 1) << 5); R = (st >> 1) * 16 + swz / 64; C = (st & 1) * 32 + (swz % 64) / 2; }
__host__ __device__ __forceinline__ int perm32(int rho) { const int n = rho >> 4, i = rho & 15; return 8 * (i >> 2) + 4 * n + (i & 3); }

struct Unit { int pm, pn; };
struct Gemm { const bf16_t* A; const bf16_t* Bt; int M, N, K; };

struct StaticOrder {
    int nM, nN, nwg, G, c;
    __host__ __device__ void init(int M, int N, int G_, int c_) { nM = M / BM; nN = N / BM; nwg = nM * nN; G = G_; c = c_; }
    __host__ __device__ bool next(int i, Unit& u) const {
        const long L = (long)i * G + c; if (L >= nwg) return false;
        int wgid = (int)L; { const int q = nwg / NXCD, r = nwg % NXCD, xcd = wgid % NXCD, off = wgid / NXCD; wgid = (xcd < r ? xcd * (q + 1) : r * (q + 1) + (xcd - r) * q) + off; }
        const int nig = WGM * nN, gid = wgid / nig, fm = gid * WGM, gsz = (nM - fm) < WGM ? (nM - fm) : WGM;
        u.pm = fm + ((wgid % nig) % gsz); u.pn = (wgid % nig) / gsz; return true;
    }
    __device__ __forceinline__ void a_ready(const Unit&) const {}
    __device__ __forceinline__ void done(const Unit&) const {}
};

__device__ __forceinline__ unsigned cvt_pk_bf16(float lo, float hi) { unsigned r; asm volatile("v_cvt_pk_bf16_f32 %0, %1, %2" : "=v"(r) : "v"(lo), "v"(hi)); return r; }
typedef float f32x2 __attribute__((ext_vector_type(2)));
template <class Epi, class Sched, bool ALIGN_EPI = false, bool SP2 = false>
__device__ __forceinline__ void gemm_phase(PG8_LAS unsigned char* lds, const Gemm g, const Sched& S, const Epi& E) {
    int tid_ = threadIdx.x; asm volatile("" : "+v"(tid_));
    const int tid = tid_, wid = __builtin_amdgcn_readfirstlane(tid >> 6), lane = tid & 63, wr = wid >> 2, wc = wid & 3, fr = lane & 15, fq = lane >> 4;
    const int K = g.K, nt = K / BK;
    unsigned voffA[2], voffB[2];
#pragma unroll
    for (int i = 0; i < 2; ++i) { int R, C; stage_rc(tid * 16 + i * 8192, R, C); const int Rb = Epi::PERM ? ((R & ~31) + perm32(R & 31)) : R;
        voffA[i] = (unsigned)(R * K + C) * 2u; voffB[i] = (unsigned)(Rb * K + C) * 2u; }
    const size_t kstep = (size_t)(BK * 2);
    const size_t hstep = (size_t)HALF * K * 2;
    const size_t tstep = 2 * hstep;
    const unsigned ldsw = (unsigned)wid * 1024u;
    const int aoff = lds_byte(wr * 64 + fr, fq * 8), boff = lds_byte(wc * 32 + fr, fq * 8);
#define PG8_SA(b, h) (((b) * 2 + (h)) * HTB)
#define PG8_SB(b, h) ((4 + (b) * 2 + (h)) * HTB)
#define PG8_STAGE(bufoff, gbase, voff) do { _Pragma("unroll") for (int _i = 0; _i < 2; ++_i) \
        __builtin_amdgcn_global_load_lds((const unsigned*)((const char*)(gbase) + (voff)[_i]), (PG8_LAS unsigned*)(lds + (bufoff) + ldsw + _i * 8192), 16, 0, 0); } while (0)
#define PG8_LDA(dst, b, h) do { _Pragma("unroll") for (int m = 0; m < 4; ++m) _Pragma("unroll") for (int k = 0; k < 2; ++k) dst[m][k] = *(const PG8_LAS bf16x8*)(lds + PG8_SA(b, h) + aoff + m * 2048 + k * 1024); } while (0)
#define PG8_LDB(dst, b, h) do { _Pragma("unroll") for (int n = 0; n < 2; ++n) _Pragma("unroll") for (int k = 0; k < 2; ++k) dst[n][k] = *(const PG8_LAS bf16x8*)(lds + PG8_SB(b, h) + boff + n * 2048 + k * 1024); } while (0)
#define PG8_MMA(ai, bj, At, Bt) do { __builtin_amdgcn_s_setprio(1); _Pragma("unroll") for (int m = 0; m < 4; ++m) _Pragma("unroll") for (int n = 0; n < 2; ++n) _Pragma("unroll") for (int k = 0; k < 2; ++k) \
        acc[ai][bj][m][n] = __builtin_amdgcn_mfma_f32_16x16x32_bf16(Bt[n][k], At[m][k], acc[ai][bj][m][n], 0, 0, 0); __builtin_amdgcn_s_setprio(0); } while (0)
#define PG8_WAIT_V(n) asm volatile("s_waitcnt vmcnt(" #n ")" ::: "memory")
#define PG8_WAIT_L(n) asm volatile("s_waitcnt lgkmcnt(" #n ")" ::: "memory")
#define PG8_BAR __builtin_amdgcn_s_barrier()
#define PG8_SCHED __builtin_amdgcn_sched_barrier(0)
    Unit cur, nxt; int ui = 0;
    if (!S.next(0, cur)) return;
    f32x4 acc[2][2][4][2];
#pragma unroll
    for (int a = 0; a < 2; ++a)
#pragma unroll
        for (int b = 0; b < 2; ++b)
#pragma unroll
            for (int m = 0; m < 4; ++m)
#pragma unroll
                for (int n = 0; n < 2; ++n) acc[a][b][m][n] = (f32x4){0.f, 0.f, 0.f, 0.f};
    bf16x8 At[4][2], B0[2][2], B1[2][2];
    const char* cA = (const char*)g.A + (size_t)cur.pm * tstep; const char* cB = (const char*)g.Bt + (size_t)cur.pn * tstep;
    S.a_ready(cur);
    if constexpr (SP2) {
        PG8_STAGE(PG8_SB(0, 0), cB, voffB); PG8_STAGE(PG8_SB(0, 1), cB + hstep, voffB); PG8_STAGE(PG8_SA(0, 0), cA, voffA); PG8_STAGE(PG8_SA(0, 1), cA + hstep, voffA);
        if (wr == 1) PG8_BAR;
        PG8_WAIT_V(2); PG8_BAR;
        PG8_STAGE(PG8_SB(1, 0), cB + kstep, voffB); PG8_STAGE(PG8_SA(1, 0), cA + kstep, voffA); PG8_STAGE(PG8_SB(1, 1), cB + hstep + kstep, voffB);
        PG8_WAIT_V(6); PG8_BAR;
    } else {
        PG8_STAGE(PG8_SB(0, 0), cB, voffB); PG8_STAGE(PG8_SA(0, 0), cA, voffA); PG8_STAGE(PG8_SB(0, 1), cB + hstep, voffB); PG8_STAGE(PG8_SA(0, 1), cA + hstep, voffA);
        if (wr == 1) PG8_BAR;
        PG8_WAIT_V(4); PG8_BAR;
        PG8_STAGE(PG8_SB(1, 0), cB + kstep, voffB); PG8_STAGE(PG8_SA(1, 0), cA + kstep, voffA); PG8_STAGE(PG8_SB(1, 1), cB + hstep + kstep, voffB);
        PG8_WAIT_V(6); PG8_BAR;
    }
    for (;;) {
        const bool has_next = S.next(ui + 1, nxt);
        const char* nA = has_next ? (const char*)g.A + (size_t)nxt.pm * tstep : cA; const char* nB = has_next ? (const char*)g.Bt + (size_t)nxt.pn * tstep : cB;
        for (int t = 0; t < nt; t += 2) {
            const bool last = (t == nt - 2);
            const char* a1 = cA + (size_t)(t + 1) * kstep;
            const char* a2 = last ? nA : cA + (size_t)(t + 2) * kstep; const char* b2 = last ? nB : cB + (size_t)(t + 2) * kstep;
            const char* a3 = a2 + kstep; const char* b3 = b2 + kstep;
            if (last && has_next) S.a_ready(nxt);
            if constexpr (SP2) {
            PG8_LDB(B0, 0, 0); PG8_LDB(B1, 0, 1); PG8_SCHED; PG8_LDA(At, 0, 0); PG8_STAGE(PG8_SA(1, 1), a1 + hstep, voffA);
            PG8_WAIT_V(8); PG8_WAIT_L(0); PG8_BAR; PG8_MMA(0, 0, At, B0); PG8_MMA(0, 1, At, B1); PG8_BAR; PG8_SCHED;
            PG8_LDA(At, 0, 1); PG8_STAGE(PG8_SB(0, 0), b2, voffB); PG8_STAGE(PG8_SB(0, 1), b2 + hstep, voffB); PG8_STAGE(PG8_SA(0, 0), a2, voffA);
            PG8_WAIT_V(8); PG8_WAIT_L(0); PG8_BAR; PG8_MMA(1, 0, At, B0); PG8_MMA(1, 1, At, B1); PG8_BAR; PG8_SCHED;
            PG8_LDB(B0, 1, 0); PG8_LDB(B1, 1, 1); PG8_SCHED; PG8_LDA(At, 1, 0); PG8_STAGE(PG8_SA(0, 1), a2 + hstep, voffA);
            PG8_WAIT_V(8); PG8_WAIT_L(0); PG8_BAR; PG8_MMA(0, 0, At, B0); PG8_MMA(0, 1, At, B1); PG8_BAR; PG8_SCHED;
            PG8_LDA(At, 1, 1); PG8_STAGE(PG8_SB(1, 0), b3, voffB); PG8_STAGE(PG8_SB(1, 1), b3 + hstep, voffB); PG8_STAGE(PG8_SA(1, 0), a3, voffA);
            PG8_WAIT_V(8); PG8_WAIT_L(0); PG8_BAR; PG8_MMA(1, 0, At, B0); PG8_MMA(1, 1, At, B1); PG8_BAR; PG8_SCHED;
            } else {
            PG8_LDB(B0, 0, 0); PG8_SCHED; PG8_LDA(At, 0, 0); PG8_STAGE(PG8_SA(1, 1), a1 + hstep, voffA);
            PG8_WAIT_L(8); PG8_BAR; PG8_WAIT_L(0); PG8_MMA(0, 0, At, B0); PG8_BAR; PG8_SCHED;
            PG8_LDB(B1, 0, 1); PG8_STAGE(PG8_SB(0, 0), b2, voffB);
            PG8_BAR; PG8_WAIT_L(0); PG8_MMA(0, 1, At, B1); PG8_BAR;
            PG8_LDA(At, 0, 1); PG8_STAGE(PG8_SA(0, 0), a2, voffA);
            PG8_BAR; PG8_WAIT_L(0); PG8_MMA(1, 0, At, B0); PG8_BAR; PG8_SCHED;
            PG8_STAGE(PG8_SB(0, 1), b2 + hstep, voffB);
            PG8_WAIT_V(6); PG8_BAR; PG8_MMA(1, 1, At, B1); PG8_BAR;
            PG8_LDB(B0, 1, 0); PG8_SCHED; PG8_LDA(At, 1, 0); PG8_STAGE(PG8_SA(0, 1), a2 + hstep, voffA);
            PG8_WAIT_L(8); PG8_BAR; PG8_WAIT_L(0); PG8_MMA(0, 0, At, B0); PG8_BAR; PG8_SCHED;
            PG8_LDB(B1, 1, 1); PG8_STAGE(PG8_SB(1, 0), b3, voffB);
            PG8_BAR; PG8_WAIT_L(0); PG8_MMA(0, 1, At, B1); PG8_BAR;
            PG8_LDA(At, 1, 1); PG8_STAGE(PG8_SA(1, 0), a3, voffA);
            PG8_BAR; PG8_WAIT_L(0); PG8_MMA(1, 0, At, B0); PG8_BAR; PG8_SCHED;
            PG8_STAGE(PG8_SB(1, 1), b3 + hstep, voffB);
            PG8_WAIT_V(6); PG8_BAR; PG8_MMA(1, 1, At, B1); PG8_BAR;
            }
        }
        if constexpr (ALIGN_EPI) { if (wr == 0) PG8_BAR; }
        if constexpr (!Epi::AFTER_DRAIN) { E(acc, cur, wr, wc, fr, fq); S.done(cur); }
        if (!has_next) break;
#pragma unroll
        for (int a = 0; a < 2; ++a)
#pragma unroll
            for (int b = 0; b < 2; ++b)
#pragma unroll
                for (int m = 0; m < 4; ++m)
#pragma unroll
                    for (int n = 0; n < 2; ++n) acc[a][b][m][n] = (f32x4){0.f, 0.f, 0.f, 0.f};
        cur = nxt; cA = nA; cB = nB; ++ui;
        if constexpr (ALIGN_EPI) { if (wr == 1) PG8_BAR; }
    }
    PG8_WAIT_V(0);
    if constexpr (!ALIGN_EPI) { if (wr == 0) PG8_BAR; }
    PG8_BAR;
    if constexpr (Epi::AFTER_DRAIN) { E.fused(acc, cur, wr, wc, fr, fq, lds, wid, lane); S.done(cur); }
#undef PG8_SA
#undef PG8_SB
#undef PG8_STAGE
#undef PG8_LDA
#undef PG8_LDB
#undef PG8_MMA
#undef PG8_WAIT_V
#undef PG8_WAIT_L
#undef PG8_BAR
#undef PG8_SCHED
}
}
#define GAS __attribute__((address_space(1)))
#define LAS __attribute__((address_space(3)))
typedef unsigned short bf16;
typedef unsigned v4u __attribute__((ext_vector_type(4)));
typedef float f32x4 __attribute__((ext_vector_type(4)));
typedef short bf16x8 __attribute__((ext_vector_type(8)));
typedef GAS unsigned gu32;
typedef GAS unsigned long long gu64;
#define RLX_AGENT __ATOMIC_RELAXED, __HIP_MEMORY_SCOPE_AGENT
#define LDS_WAIT() asm volatile("s_waitcnt lgkmcnt(0)" ::: "memory")
#define VM_WAIT() asm volatile("s_waitcnt vmcnt(0)" ::: "memory")
__device__ __forceinline__ unsigned long long rt() { return __builtin_amdgcn_s_memrealtime(); }
__device__ __forceinline__ unsigned f2bf(float f) { unsigned u = __builtin_bit_cast(unsigned, f); return (u + 0x7fffu + ((u >> 16) & 1u)) >> 16; }
__device__ __forceinline__ unsigned pk2(float lo, float hi) { return f2bf(lo) | (f2bf(hi) << 16); }
typedef float f32x2v_t __attribute__((ext_vector_type(2)));
#define XB_TMO      128
#define XB_XCNT(j)  (256  + 64 * (j))
#define XB_XSUB(j)  (1280 + 64 * (j))
#define XB_XGEN(j)  (2304 + 64 * (j))
#define XB_TOP      3328
#define XB_TOPGEN   3392
#define XCD_BAR_WORDS 3456
#define XB_SPIN_CAP (1u << 18)

__device__ __forceinline__ unsigned xb_ld(unsigned* p)              { return __hip_atomic_load(p, __ATOMIC_RELAXED, __HIP_MEMORY_SCOPE_AGENT); }
__device__ __forceinline__ unsigned xb_add(unsigned* p, unsigned v) { return __hip_atomic_fetch_add(p, v, __ATOMIC_RELAXED, __HIP_MEMORY_SCOPE_AGENT); }
__device__ __forceinline__ unsigned xb_xcc_id() { return (unsigned)__builtin_amdgcn_s_getreg((3 << 11) | 20) & 0xFu; }
#define XB_SPIN(cond, bar) do { unsigned _sp = 0; while (cond) { __builtin_amdgcn_s_sleep(1); \
    if ((++_sp & 255u) == 0u) { if (xb_ld(&(bar)[XB_TMO])) break; if (_sp > XB_SPIN_CAP) { atomicAdd(&(bar)[XB_TMO], 1u); break; } } } } while (0)

struct XcdBarrier {
    unsigned* bar; unsigned x;
    volatile LAS unsigned* st;
};

__device__ __forceinline__ XcdBarrier xcd_barrier_post(unsigned* bar, volatile LAS unsigned* st) {
    XcdBarrier b; b.bar = bar; b.x = xb_xcc_id(); b.st = st;
    if (threadIdx.x == 0) (void)xb_add(&bar[XB_XCNT(b.x)], 1u);
    return b;
}
__device__ __forceinline__ void xcd_barrier_complete(unsigned* bar, unsigned x, unsigned& nloc, unsigned& nx) {
    const unsigned G = gridDim.x * gridDim.y * gridDim.z;
    unsigned sum, cnt, mine, sp = 0u;
    for (;;) {
        sum = 0u; cnt = 0u; mine = 0u;
#pragma unroll
        for (unsigned j = 0; j < 16; ++j) { const unsigned c = xb_ld(&bar[XB_XCNT(j)]); sum += c; cnt += (c > 0u) ? 1u : 0u; mine = (j == x) ? c : mine; }
        if (sum == G) break;
        __builtin_amdgcn_s_sleep(1);
        if ((++sp & 255u) == 0u) { if (xb_ld(&bar[XB_TMO])) break; if (sp > XB_SPIN_CAP) { atomicAdd(&bar[XB_TMO], 1u); break; } }
    }
    nloc = mine > 0u ? mine : 1u; nx = cnt > 0u ? cnt : 1u;
}

__device__ __forceinline__ void xcd_barrier(const XcdBarrier& b) {
    asm volatile("s_waitcnt vmcnt(0)" ::: "memory");
    __syncthreads();
    if (threadIdx.x == 0) {
        unsigned* bar = b.bar;
        __builtin_amdgcn_s_waitcnt(0);
        unsigned nloc = b.st[0], nx = b.st[1];
        if (nloc == 0u) { xcd_barrier_complete(bar, b.x, nloc, nx); b.st[0] = nloc; b.st[1] = nx; }
        const unsigned old = xb_add(&bar[XB_XSUB(b.x)], 1u);
        const unsigned gen = old / nloc;
        if (old + 1u == (gen + 1u) * nloc) {
            __builtin_amdgcn_fence(__ATOMIC_RELEASE, "agent");
            asm volatile("s_waitcnt vmcnt(0)" ::: "memory");
            const unsigned og = xb_add(&bar[XB_TOP], 1u);
            const unsigned tg = og / nx;
            if (og + 1u == (tg + 1u) * nx) xb_add(&bar[XB_TOPGEN], 1u);
            else XB_SPIN(xb_ld(&bar[XB_TOPGEN]) == tg, bar);
            __builtin_amdgcn_fence(__ATOMIC_ACQUIRE, "agent");
            xb_add(&bar[XB_XGEN(b.x)], 1u);
            asm volatile("s_waitcnt vmcnt(0)" ::: "memory");
        } else {
            XB_SPIN(xb_ld(&bar[XB_XGEN(b.x)]) == gen, bar);
            __builtin_amdgcn_fence(__ATOMIC_ACQUIRE, "agent");
            asm volatile("s_waitcnt vmcnt(0)" ::: "memory");
        }
    }
    __syncthreads();
}

constexpr int NWAVES = 8;
constexpr int BATCH = 8, SEQ = 4096, DM = 2048, DEPTH = 4;
constexpr int M = BATCH * SEQ;
constexpr int NHEAD = 8, QKD = 64, VD = 128;
constexpr int QKW = 1024, AW = 1024, LW = 1024, INW = 5120, DFF = 6144, DFF2 = 12288;
constexpr int LBLK = 128, NLB = 8;
constexpr int MH = M / 2;
constexpr float EPS = 1e-6f;
constexpr float C2 = 0.125f * 1.4426950408889634f;
constexpr int LCH = 64, NCH = SEQ / LCH;

constexpr size_t MiB = 1u << 20;
constexpr size_t WS_CTL = 0, CTL_ZERO_BYTES = 1 * MiB;
constexpr size_t WS_WG = 1 * MiB;
constexpr size_t WS_COS = 3 * MiB, WS_SIN = 7 * MiB;
constexpr size_t WS_RSTD = 11 * MiB;
constexpr size_t WS_SS = 12 * MiB;
constexpr size_t WS_CHP = 16 * MiB, WS_CHH = 18 * MiB;
constexpr size_t WS_WIN = 20 * MiB;
constexpr size_t WS_WOUT = 100 * MiB;
constexpr size_t WS_WUP = 132 * MiB;
constexpr size_t WS_WDN = 324 * MiB;
constexpr size_t WS_XB = 420 * MiB;
constexpr size_t WS_Q = 548 * MiB, WS_K = 612 * MiB, WS_VT = 676 * MiB, WS_XBR = 740 * MiB, WS_GB = 804 * MiB;
constexpr size_t WS_MIX = 868 * MiB;
constexpr size_t WS_HLOC = 996 * MiB, WS_CUMA = 1124 * MiB;
constexpr size_t WS_STASH = 1252 * MiB;
constexpr size_t WS_U = 548 * MiB;
constexpr size_t WS_ACT = 932 * MiB;
constexpr size_t WS_END = 1380 * MiB;
constexpr int CW_BAR = 4096;

constexpr int RING_OFF = 0, RING_BYTES = 131072;
constexpr int LDSCTL_OFF = RING_BYTES, MISC_OFF = LDSCTL_OFF + 320;
constexpr int LDS_BYTES = 147456;
constexpr int PTR_OFF = LDSCTL_OFF + 1024;
#ifndef REP_P1
#define REP_P1 1
#endif
#ifndef REP_ATTN
#define REP_ATTN 1
#endif
#ifndef REP_LRUL
#define REP_LRUL 1
#endif
#ifndef REP_LRUF
#define REP_LRUF 1
#endif
#ifndef REP_UP
#define REP_UP 1
#endif
#ifndef REP_FFNC
#define REP_FFNC 1
#endif
#ifndef REP_P4
#define REP_P4 1
#endif
#ifndef REP_P7
#define REP_P7 1
#endif
#ifndef REP_PRO
#define REP_PRO 1
#endif

typedef float f32x16 __attribute__((ext_vector_type(16)));
typedef unsigned u32x2 __attribute__((ext_vector_type(2)));
typedef const LAS unsigned char* lds_cp;

__device__ __forceinline__ float wave_sum(float v) {
#pragma unroll
    for (int o = 1; o < 64; o <<= 1) v += __shfl_xor(v, o);
    return v;
}
__device__ __forceinline__ float bf2f(unsigned short h) { return __uint_as_float(((unsigned)h) << 16); }
__device__ __forceinline__ float bflo(unsigned w) { return __uint_as_float(w << 16); }
__device__ __forceinline__ float bfhi(unsigned w) { return __uint_as_float(w & 0xffff0000u); }
__device__ __forceinline__ float ex2(float x) { return __builtin_amdgcn_exp2f(x); }
__device__ __forceinline__ float gelu_tanh(float x) {
    const float z = x * (1.0f + 0.044715f * x * x) * (-2.0f * 0.7978845608028654f * 1.4426950408889634f);
    return x * __builtin_amdgcn_rcpf(1.0f + ex2(z));
}
__device__ __forceinline__ float sigmoidf_(float x) { return __builtin_amdgcn_rcpf(1.0f + ex2(-1.4426950408889634f * x)); }

__device__ __forceinline__ const void* ldptr(LAS unsigned char* lds, int i) {
    const LAS unsigned* p = (const LAS unsigned*)(lds + PTR_OFF) + 2 * i; const unsigned lo = __builtin_amdgcn_readfirstlane(p[0]), hi = __builtin_amdgcn_readfirstlane(p[1]);
    return (const void*)(((unsigned long long)hi << 32) | lo);
}
struct EpiInProj {
    static constexpr bool PERM = true, AFTER_DRAIN = false;
    const float* rstd; const float* cosT; const float* sinT; bf16* Q; bf16* Kk; bf16* XBR; bf16* GB;
    __device__ __forceinline__ void operator()(const pg8::f32x4 (&acc)[2][2][4][2], const pg8::Unit& u, int wr, int wc, int fr, int fq) const {
        const int row0 = u.pm * 256 + wr * 64 + fr; const int typ = u.pn >> 2, tt = u.pn & 3;
        if (typ < 2) {
            bf16* O = typ == 0 ? Q : Kk; const float sc = typ == 0 ? C2 : 1.0f;
            const int colb = tt * 256 + wc * 64 + 8 * fq;
#pragma unroll
            for (int ai = 0; ai < 2; ++ai)
#pragma unroll
                for (int m = 0; m < 4; ++m) {
                    const int row = row0 + ai * 128 + m * 16; const float rs = rstd[row] * sc;
                    const f32x4 c0 = *(const f32x4*)(cosT + (size_t)row * 32 + 8 * fq), c1 = *(const f32x4*)(cosT + (size_t)row * 32 + 8 * fq + 4);
                    const f32x4 s0 = *(const f32x4*)(sinT + (size_t)row * 32 + 8 * fq), s1 = *(const f32x4*)(sinT + (size_t)row * 32 + 8 * fq + 4);
                    const f32x4 a0 = acc[ai][0][m][0] * rs, a1 = acc[ai][0][m][1] * rs, b0 = acc[ai][1][m][0] * rs, b1 = acc[ai][1][m][1] * rs;
                    const f32x4 p0 = a0 * c0 - b0 * s0, p1 = a1 * c1 - b1 * s1, q0 = b0 * c0 + a0 * s0, q1 = b1 * c1 + a1 * s1;
                    v4u w1, w2;
                    w1.x = pg8::cvt_pk_bf16(p0[0], p0[1]); w1.y = pg8::cvt_pk_bf16(p0[2], p0[3]); w1.z = pg8::cvt_pk_bf16(p1[0], p1[1]); w1.w = pg8::cvt_pk_bf16(p1[2], p1[3]);
                    w2.x = pg8::cvt_pk_bf16(q0[0], q0[1]); w2.y = pg8::cvt_pk_bf16(q0[2], q0[3]); w2.z = pg8::cvt_pk_bf16(q1[0], q1[1]); w2.w = pg8::cvt_pk_bf16(q1[2], q1[3]);
                    bf16* rp = O + (size_t)row * 1024 + colb;
                    *(v4u*)rp = w1; *(v4u*)(rp + 32) = w2;
                }
        } else {
            bf16* O = typ == 2 ? XBR : GB; const int col0 = tt * 256 + wc * 32 + 8 * fq;
#pragma unroll
            for (int ai = 0; ai < 2; ++ai)
#pragma unroll
                for (int m = 0; m < 4; ++m) {
                    const int row = row0 + ai * 128 + m * 16; const float rs = rstd[row];
#pragma unroll
                    for (int bj = 0; bj < 2; ++bj) {
                        const f32x4 v0 = acc[ai][bj][m][0] * rs, v1 = acc[ai][bj][m][1] * rs; v4u w;
                        w.x = pg8::cvt_pk_bf16(v0[0], v0[1]); w.y = pg8::cvt_pk_bf16(v0[2], v0[3]); w.z = pg8::cvt_pk_bf16(v1[0], v1[1]); w.w = pg8::cvt_pk_bf16(v1[2], v1[3]);
                        *(v4u*)(O + (size_t)row * 1024 + col0 + bj * 128) = w;
                    }
                }
        }
    }
};
struct EpiVt {
    static constexpr bool PERM = true, AFTER_DRAIN = false;
    const float* rstd; bf16* Vt;
    __device__ __forceinline__ void operator()(const pg8::f32x4 (&acc)[2][2][4][2], const pg8::Unit& u, int wr, int wc, int fr, int fq) const {
        const int row0 = u.pm * 256 + wr * 64 + fr, col0 = u.pn * 256 + wc * 32 + 8 * fq;
        f32x4 rs[2][2];
#pragma unroll
        for (int bj = 0; bj < 2; ++bj) { rs[bj][0] = *(const f32x4*)(rstd + col0 + bj * 128); rs[bj][1] = *(const f32x4*)(rstd + col0 + bj * 128 + 4); }
#pragma unroll
        for (int ai = 0; ai < 2; ++ai)
#pragma unroll
            for (int m = 0; m < 4; ++m) {
                const int row = row0 + ai * 128 + m * 16;
#pragma unroll
                for (int bj = 0; bj < 2; ++bj) {
                    const f32x4 v0 = acc[ai][bj][m][0] * rs[bj][0], v1 = acc[ai][bj][m][1] * rs[bj][1]; v4u w;
                    w.x = pg8::cvt_pk_bf16(v0[0], v0[1]); w.y = pg8::cvt_pk_bf16(v0[2], v0[3]); w.z = pg8::cvt_pk_bf16(v1[0], v1[1]); w.w = pg8::cvt_pk_bf16(v1[2], v1[3]);
                    *(v4u*)(Vt + (size_t)row * M + col0 + bj * 128) = w;
                }
            }
    }
};
struct EpiResid {
    static constexpr bool PERM = false, AFTER_DRAIN = false;
    const float* xold; float* X; bf16* XB; float* SS; int row_off;
    __device__ __forceinline__ void operator()(const pg8::f32x4 (&acc)[2][2][4][2], const pg8::Unit& u, int wr, int wc, int fr, int fq) const {
        const int row0 = row_off + u.pm * 256 + wr * 64 + fr, col0 = u.pn * 256 + wc * 32 + 4 * fq;
#pragma unroll
        for (int ai = 0; ai < 2; ++ai)
#pragma unroll
            for (int m = 0; m < 4; ++m) {
                const int row = row0 + ai * 128 + m * 16; const size_t off = (size_t)row * DM + col0; float s = 0.f;
#pragma unroll
                for (int bj = 0; bj < 2; ++bj)
#pragma unroll
                    for (int n = 0; n < 2; ++n) {
                        const f32x4 xo = *(const f32x4*)(xold + off + bj * 128 + n * 16); const f32x4 v = xo + acc[ai][bj][m][n];
                        *(f32x4*)(X + off + bj * 128 + n * 16) = v;
                        u32x2 w; w.x = pg8::cvt_pk_bf16(v[0], v[1]); w.y = pg8::cvt_pk_bf16(v[2], v[3]);
                        *(u32x2*)(XB + off + bj * 128 + n * 16) = w;
                        s += (v[0] * v[0] + v[1] * v[1]) + (v[2] * v[2] + v[3] * v[3]);
                    }
                s += __shfl_xor(s, 16); s += __shfl_xor(s, 32);
                if (fq == 0) SS[(size_t)row * 32 + u.pn * 4 + wc] = s;
                asm volatile("" ::: "memory");
            }
    }
};
struct EpiUp {
    static constexpr bool PERM = true, AFTER_DRAIN = false;
    const float* rstd; bf16* U;
    __device__ __forceinline__ void operator()(const pg8::f32x4 (&acc)[2][2][4][2], const pg8::Unit& u, int wr, int wc, int fr, int fq) const {
        const int row0 = u.pm * 256 + wr * 64 + fr, col0 = u.pn * 256 + wc * 32 + 8 * fq;
#pragma unroll
        for (int ai = 0; ai < 2; ++ai)
#pragma unroll
            for (int m = 0; m < 4; ++m) {
                const int row = row0 + ai * 128 + m * 16; const float rs = rstd[row];
#pragma unroll
                for (int bj = 0; bj < 2; ++bj) {
                    const f32x4 v0 = acc[ai][bj][m][0] * rs, v1 = acc[ai][bj][m][1] * rs; v4u w;
                    w.x = pg8::cvt_pk_bf16(v0[0], v0[1]); w.y = pg8::cvt_pk_bf16(v0[2], v0[3]); w.z = pg8::cvt_pk_bf16(v1[0], v1[1]); w.w = pg8::cvt_pk_bf16(v1[2], v1[3]);
                    *(v4u*)(U + (size_t)row * DFF2 + col0 + bj * 128) = w;
                }
            }
    }
};

__device__ __forceinline__ void attn_unit(LAS unsigned char* lds, const bf16* Q, const bf16* Kk, const bf16* Vt, bf16* MIX, f32x4* stash, int b, int h, int qb, float lam) {
    int tid_ = threadIdx.x; asm volatile("" : "+v"(tid_));
    const int tid = tid_, lane = tid & 63, r32 = lane & 31, hi = lane >> 5; const int w = __builtin_amdgcn_readfirstlane(tid >> 6);
    LAS unsigned char* Kl = lds; LAS unsigned char* Vl = lds + 8192;
    const size_t rowbase = (size_t)b * SEQ; const int q0 = qb * 256, NT = (q0 + 256) / 64;
    const int qpos = q0 + 32 * w + r32, wqmin = q0 + 32 * w;
    const int krow = tid >> 3, kch = tid & 7; const int koff = krow * 128 + ((kch ^ ((krow >> 1) & 7)) << 4);
    const int vd0 = tid >> 3, vd1 = vd0 + 64; const int voff0 = vd0 * 128 + ((kch ^ ((vd0 >> 1) & 7)) << 4), voff1 = vd1 * 128 + ((kch ^ ((vd1 >> 1) & 7)) << 4);
    const bf16* vsrc0 = Vt + (size_t)(h * 128 + vd0) * M + rowbase + 8 * kch; const bf16* vsrc1 = vsrc0 + (size_t)64 * M;
    const int pi = (r32 & 0x13) | ((r32 & 4) << 1) | ((r32 & 8) >> 1); const int swk = (pi >> 1) & 7, swv = (r32 >> 1) & 7;
    const int kfb = pi * 128, vfb = r32 * 128;
    f32x4* st = stash + (size_t)w * 16 * 64 + lane;
#pragma unroll 1
    for (int c = 0; c < 2; ++c) {
        const bf16* Qp = Q + (rowbase + qpos) * 1024 + h * 128 + c * 64 + 8 * hi;
        bf16x8 qr[4];
#pragma unroll
        for (int ds = 0; ds < 4; ++ds) qr[ds] = *(const bf16x8*)(Qp + 16 * ds);
        const bf16* ksrc = Kk + (rowbase + krow) * 1024 + h * 128 + c * 64 + 8 * kch;
        f32x16 oT[4];
#pragma unroll
        for (int db = 0; db < 4; ++db)
#pragma unroll
            for (int i = 0; i < 16; ++i) oT[db][i] = 0.f;
        float mrun = -INFINITY, lsum = 0.f;
        v4u pk = *(const v4u*)ksrc, pv0 = *(const v4u*)vsrc0, pv1 = *(const v4u*)vsrc1;
#pragma unroll 1
        for (int kt = 0; kt < NT; ++kt) {
            __syncthreads();
            *(LAS v4u*)(Kl + koff) = pk; *(LAS v4u*)(Vl + voff0) = pv0; *(LAS v4u*)(Vl + voff1) = pv1;
            if (kt + 1 < NT) { pk = *(const v4u*)(ksrc + (size_t)(kt + 1) * 64 * 1024); pv0 = *(const v4u*)(vsrc0 + (kt + 1) * 64); pv1 = *(const v4u*)(vsrc1 + (kt + 1) * 64); }
            __syncthreads();
            if (64 * kt > wqmin + 31) continue;
            f32x16 p[2];
#pragma unroll
            for (int kb = 0; kb < 2; ++kb) {
#pragma unroll
                for (int i = 0; i < 16; ++i) p[kb][i] = 0.f;
#pragma unroll
                for (int ds = 0; ds < 4; ++ds) {
                    const bf16x8 kf = *(const LAS bf16x8*)(Kl + kb * 4096 + kfb + (((2 * ds + hi) ^ swk) << 4));
                    p[kb] = __builtin_amdgcn_mfma_f32_32x32x16_bf16(kf, qr[ds], p[kb], 0, 0, 0);
                }
            }
            if (64 * kt + 63 > wqmin) {
                const int kbase = 64 * kt + 8 * hi;
#pragma unroll
                for (int kb = 0; kb < 2; ++kb)
#pragma unroll
                    for (int i = 0; i < 16; ++i) { const int key = kbase + 32 * kb + 16 * (i >> 3) + (i & 7); if (key > qpos) p[kb][i] = -INFINITY; }
            }
            float mx = p[0][0];
#pragma unroll
            for (int i = 1; i < 16; ++i) mx = fmaxf(mx, p[0][i]);
#pragma unroll
            for (int i = 0; i < 16; ++i) mx = fmaxf(mx, p[1][i]);
            mx = fmaxf(mx, __shfl_xor(mx, 32));
            const float mnew = fmaxf(mrun, mx); const float alpha = ex2(mrun - mnew); mrun = mnew;
            float rs = 0.f;
#pragma unroll
            for (int kb = 0; kb < 2; ++kb)
#pragma unroll
                for (int i = 0; i < 16; ++i) { const float e = ex2(p[kb][i] - mnew); p[kb][i] = e; rs += e; }
            lsum = lsum * alpha + rs;
#pragma unroll
            for (int db = 0; db < 4; ++db)
#pragma unroll
                for (int i = 0; i < 16; ++i) oT[db][i] *= alpha;
            bf16x8 pf[4];
#pragma unroll
            for (int s = 0; s < 4; ++s) {
                const int kb = s >> 1, o = 8 * (s & 1); v4u t;
                t.x = pg8::cvt_pk_bf16(p[kb][o + 0], p[kb][o + 1]); t.y = pg8::cvt_pk_bf16(p[kb][o + 2], p[kb][o + 3]);
                t.z = pg8::cvt_pk_bf16(p[kb][o + 4], p[kb][o + 5]); t.w = pg8::cvt_pk_bf16(p[kb][o + 6], p[kb][o + 7]);
                pf[s] = __builtin_bit_cast(bf16x8, t);
            }
#pragma unroll
            for (int db = 0; db < 4; ++db)
#pragma unroll
                for (int s = 0; s < 4; ++s) {
                    const bf16x8 vf = *(const LAS bf16x8*)(Vl + db * 4096 + vfb + (((2 * s + hi) ^ swv) << 4));
                    oT[db] = __builtin_amdgcn_mfma_f32_32x32x16_bf16(vf, pf[s], oT[db], 0, 0, 0);
                }
        }
        const float lt = lsum + __shfl_xor(lsum, 32); const float inv = 1.0f / lt;
        if (c == 0) {
#pragma unroll
            for (int db = 0; db < 4; ++db)
#pragma unroll
                for (int g = 0; g < 4; ++g) { f32x4 v; v[0] = oT[db][4 * g] * inv; v[1] = oT[db][4 * g + 1] * inv; v[2] = oT[db][4 * g + 2] * inv; v[3] = oT[db][4 * g + 3] * inv; st[(db * 4 + g) * 64] = v; }
        } else {
            const float li = lam * inv; float ss = 0.f;
#pragma unroll
            for (int db = 0; db < 4; ++db)
#pragma unroll
                for (int g = 0; g < 4; ++g) { const f32x4 o0 = st[(db * 4 + g) * 64];
#pragma unroll
                    for (int e = 0; e < 4; ++e) { const float o = o0[e] - li * oT[db][4 * g + e]; oT[db][4 * g + e] = o; ss += o * o; } }
            ss += __shfl_xor(ss, 32);
            const float rn = 1.0f / sqrtf(ss * (1.0f / 128.0f) + EPS);
            bf16* op = MIX + (rowbase + qpos) * DM + h * 128 + 4 * hi;
#pragma unroll
            for (int db = 0; db < 4; ++db)
#pragma unroll
                for (int g = 0; g < 4; ++g) { u32x2 wv; wv.x = pg8::cvt_pk_bf16(oT[db][4 * g] * rn, oT[db][4 * g + 1] * rn); wv.y = pg8::cvt_pk_bf16(oT[db][4 * g + 2] * rn, oT[db][4 * g + 3] * rn);
                    *(u32x2*)(op + 32 * db + 8 * g) = wv; }
        }
    }
}

constexpr int L_XCB = 0, XCB_STRIDE = 272, L_AF = 17408, L_BF = L_AF + 32768, L_SUB = L_BF + 32768;
__device__ __forceinline__ void lru_local_unit(LAS unsigned char* lds, const bf16* XBR, const float* cw, const float* cbias, const bf16* WG, const float* gab, const float* gxb, const float* lam_p,
                                               float* HLOC, float* CUMA, float* CHP, float* CHH, int b, int ck, int hb) {
    int tid_ = threadIdx.x; asm volatile("" : "+v"(tid_));
    const int tid = tid_, lane = tid & 63; const int w = __builtin_amdgcn_readfirstlane(tid >> 6);
    LAS float* AF = (LAS float*)(lds + L_AF); LAS float* BF = (LAS float*)(lds + L_BF); LAS float* SUBP = (LAS float*)(lds + L_SUB); LAS float* SUBH = SUBP + 512;
    const size_t rowbase = (size_t)b * SEQ; const int t0 = ck * LCH;
    __syncthreads();
#pragma unroll
    for (int it = 0; it < 2; ++it) {
        const int item = tid + 512 * it; const int tl = item >> 4, cg = item & 15; const int t = t0 + tl; const int ch = hb * 128 + cg * 8;
        float xc[8];
        { const f32x4 b0 = *(const f32x4*)(cbias + ch), b1 = *(const f32x4*)(cbias + ch + 4); xc[0] = b0[0]; xc[1] = b0[1]; xc[2] = b0[2]; xc[3] = b0[3]; xc[4] = b1[0]; xc[5] = b1[1]; xc[6] = b1[2]; xc[7] = b1[3]; }
#pragma unroll
        for (int j = 0; j < 4; ++j) {
            const int ts = t - 3 + j;
            if (ts >= 0) {
                const v4u xv = *(const v4u*)(XBR + (rowbase + ts) * 1024 + ch);
                const f32x4 w0 = *(const f32x4*)(cw + j * LW + ch), w1 = *(const f32x4*)(cw + j * LW + ch + 4);
                xc[0] += w0[0] * bflo(xv.x); xc[1] += w0[1] * bfhi(xv.x); xc[2] += w0[2] * bflo(xv.y); xc[3] += w0[3] * bfhi(xv.y);
                xc[4] += w1[0] * bflo(xv.z); xc[5] += w1[1] * bfhi(xv.z); xc[6] += w1[2] * bflo(xv.w); xc[7] += w1[3] * bfhi(xv.w);
            }
        }
        v4u pw; pw.x = pg8::cvt_pk_bf16(xc[0], xc[1]); pw.y = pg8::cvt_pk_bf16(xc[2], xc[3]); pw.z = pg8::cvt_pk_bf16(xc[4], xc[5]); pw.w = pg8::cvt_pk_bf16(xc[6], xc[7]);
        *(LAS v4u*)(lds + L_XCB + tl * XCB_STRIDE + cg * 16) = pw;
        f32x4 f0, f1; f0[0] = xc[0]; f0[1] = xc[1]; f0[2] = xc[2]; f0[3] = xc[3]; f1[0] = xc[4]; f1[1] = xc[5]; f1[2] = xc[6]; f1[3] = xc[7];
        *(LAS f32x4*)(BF + tl * 128 + cg * 8) = f0; *(LAS f32x4*)(BF + tl * 128 + cg * 8 + 4) = f1;
    }
    __syncthreads();
    {
        const int n = lane & 15, quad = lane >> 4; const int chl = 16 * w + n, chg = hb * 128 + chl;
        bf16x8 bw[2][4];
#pragma unroll
        for (int g = 0; g < 2; ++g)
#pragma unroll
            for (int ks = 0; ks < 4; ++ks) bw[g][ks] = *(const bf16x8*)(WG + ((size_t)(hb * 2 + g) * 128 + chl) * 128 + 32 * ks + 8 * quad);
        const float ba = gab[chg], bx = gxb[chg];
        const float lp = lam_p[chg]; const float sp8 = -8.0f * log1pf(expf(-lp));
#pragma unroll
        for (int mt = 0; mt < 4; ++mt) {
            f32x4 ga = {0.f, 0.f, 0.f, 0.f}, gx = {0.f, 0.f, 0.f, 0.f};
#pragma unroll
            for (int ks = 0; ks < 4; ++ks) {
                const bf16x8 af = *(const LAS bf16x8*)(lds + L_XCB + (16 * mt + n) * XCB_STRIDE + (32 * ks + 8 * quad) * 2);
                ga = __builtin_amdgcn_mfma_f32_16x16x32_bf16(af, bw[0][ks], ga, 0, 0, 0);
                gx = __builtin_amdgcn_mfma_f32_16x16x32_bf16(af, bw[1][ks], gx, 0, 0, 0);
            }
#pragma unroll
            for (int jj = 0; jj < 4; ++jj) {
                const int tl = 16 * mt + 4 * quad + jj;
                const float r = sigmoidf_(ga[jj] + ba), ig = sigmoidf_(gx[jj] + bx);
                const float la = sp8 * r; const float a = expf(la); const float mult = sqrtf(-expm1f(2.0f * la));
                const float xcv = BF[tl * 128 + chl];
                AF[tl * 128 + chl] = a; BF[tl * 128 + chl] = mult * ig * xcv;
            }
        }
    }
    __syncthreads();
    const int ch = tid & 127, sub = tid >> 7;
    {
        float hh = 0.f, P = 1.f;
#pragma unroll
        for (int tt = 0; tt < 16; ++tt) { const int idx = (16 * sub + tt) * 128 + ch; const float a = AF[idx], bb = BF[idx]; hh = a * hh + bb; P *= a; BF[idx] = hh; AF[idx] = P; }
        SUBP[sub * 128 + ch] = P; SUBH[sub * 128 + ch] = hh;
    }
    __syncthreads();
    {
        float carry = 0.f, Pp = 1.f;
#pragma unroll
        for (int s = 0; s < 3; ++s) if (s < sub) { const float ps = SUBP[s * 128 + ch]; carry = ps * carry + SUBH[s * 128 + ch]; Pp *= ps; }
        const size_t gbase = (rowbase + t0 + 16 * sub) * 1024 + hb * 128 + ch;
#pragma unroll
        for (int tt = 0; tt < 16; ++tt) { const int idx = (16 * sub + tt) * 128 + ch; const float pl = AF[idx]; HLOC[gbase + (size_t)tt * 1024] = BF[idx] + pl * carry; CUMA[gbase + (size_t)tt * 1024] = pl * Pp; }
        if (sub == 3) { const float p3 = SUBP[3 * 128 + ch]; const size_t so = ((size_t)b * NCH + ck) * 1024 + hb * 128 + ch; CHP[so] = Pp * p3; CHH[so] = p3 * carry + SUBH[3 * 128 + ch]; }
    }
}

__device__ __forceinline__ void lru_fix_unit(LAS unsigned char* lds, const float* HLOC, const float* CUMA, const float* CHP, const float* CHH, const bf16* GB, bf16* MIX, int b, int ck) {
    int tid_ = threadIdx.x; asm volatile("" : "+v"(tid_));
    const int tid = tid_, lane = tid & 63; const int w = __builtin_amdgcn_readfirstlane(tid >> 6);
    LAS float* CARRY = (LAS float*)lds;
    __syncthreads();
    {
        float c0 = 0.f, c1 = 0.f; const size_t so = (size_t)b * NCH * 1024 + 2 * tid;
#pragma unroll 4
        for (int k = 0; k < ck; ++k) { const f32x2v_t pp = *(const f32x2v_t*)(CHP + so + (size_t)k * 1024), hh = *(const f32x2v_t*)(CHH + so + (size_t)k * 1024); c0 = pp.x * c0 + hh.x; c1 = pp.y * c1 + hh.y; }
        CARRY[2 * tid] = c0; CARRY[2 * tid + 1] = c1;
    }
    __syncthreads();
    float cr[16];
#pragma unroll
    for (int g = 0; g < 2; ++g) { const int cb = g * 512 + lane * 8; const f32x4 a = *(const LAS f32x4*)(CARRY + cb), bq = *(const LAS f32x4*)(CARRY + cb + 4);
        cr[g * 8 + 0] = a[0]; cr[g * 8 + 1] = a[1]; cr[g * 8 + 2] = a[2]; cr[g * 8 + 3] = a[3]; cr[g * 8 + 4] = bq[0]; cr[g * 8 + 5] = bq[1]; cr[g * 8 + 6] = bq[2]; cr[g * 8 + 7] = bq[3]; }
#pragma unroll 1
    for (int k = 0; k < 8; ++k) {
        const size_t row = (size_t)b * SEQ + ck * LCH + w + 8 * k; float y[16]; float ss = 0.f;
#pragma unroll
        for (int g = 0; g < 2; ++g) {
            const int cb = g * 512 + lane * 8;
            const f32x4 h0 = *(const f32x4*)(HLOC + row * 1024 + cb), h1 = *(const f32x4*)(HLOC + row * 1024 + cb + 4);
            const f32x4 p0 = *(const f32x4*)(CUMA + row * 1024 + cb), p1 = *(const f32x4*)(CUMA + row * 1024 + cb + 4);
            const v4u gv = *(const v4u*)(GB + row * 1024 + cb);
            const float gg[8] = {bflo(gv.x), bfhi(gv.x), bflo(gv.y), bfhi(gv.y), bflo(gv.z), bfhi(gv.z), bflo(gv.w), bfhi(gv.w)};
#pragma unroll
            for (int e = 0; e < 4; ++e) { const float hv = h0[e] + p0[e] * cr[g * 8 + e]; const float yv = hv * gelu_tanh(gg[e]); y[g * 8 + e] = yv; ss += yv * yv; }
#pragma unroll
            for (int e = 0; e < 4; ++e) { const float hv = h1[e] + p1[e] * cr[g * 8 + 4 + e]; const float yv = hv * gelu_tanh(gg[4 + e]); y[g * 8 + 4 + e] = yv; ss += yv * yv; }
        }
        ss = wave_sum(ss); const float rn = 1.0f / sqrtf(ss * (1.0f / 1024.0f) + EPS);
#pragma unroll
        for (int g = 0; g < 2; ++g) { v4u o; o.x = pg8::cvt_pk_bf16(y[g * 8] * rn, y[g * 8 + 1] * rn); o.y = pg8::cvt_pk_bf16(y[g * 8 + 2] * rn, y[g * 8 + 3] * rn);
            o.z = pg8::cvt_pk_bf16(y[g * 8 + 4] * rn, y[g * 8 + 5] * rn); o.w = pg8::cvt_pk_bf16(y[g * 8 + 6] * rn, y[g * 8 + 7] * rn);
            *(v4u*)(MIX + row * DM + 1024 + g * 512 + lane * 8) = o; }
    }
}

__device__ __forceinline__ void ffn_conv_phase(const bf16* U, bf16* ACT, const float* cw, const float* cb, int vcu, int G, int tid) {
    const int nth = G * 512;
#pragma unroll 1
    for (int id = vcu * 512 + tid; id < (MH / 16) * (DFF / 8); id += nth) {
        const int tc = id / (DFF / 8), cg = id - tc * (DFF / 8); const int r0 = tc * 16, c = cg * 8;
        float wg[3][8], wv[3][8], bg[8], bv[8];
#pragma unroll
        for (int j = 0; j < 3; ++j) {
            const f32x4 a0 = *(const f32x4*)(cw + j * DFF2 + c), a1 = *(const f32x4*)(cw + j * DFF2 + c + 4), v0 = *(const f32x4*)(cw + j * DFF2 + DFF + c), v1 = *(const f32x4*)(cw + j * DFF2 + DFF + c + 4);
#pragma unroll
            for (int e = 0; e < 4; ++e) { wg[j][e] = a0[e]; wg[j][4 + e] = a1[e]; wv[j][e] = v0[e]; wv[j][4 + e] = v1[e]; }
        }
        { const f32x4 a0 = *(const f32x4*)(cb + c), a1 = *(const f32x4*)(cb + c + 4), v0 = *(const f32x4*)(cb + DFF + c), v1 = *(const f32x4*)(cb + DFF + c + 4);
#pragma unroll
          for (int e = 0; e < 4; ++e) { bg[e] = a0[e]; bg[4 + e] = a1[e]; bv[e] = v0[e]; bv[4 + e] = v1[e]; } }
        float g2[8], g1[8], v2[8], v1_[8];
        const bool seq_start = ((r0 & (SEQ - 1)) == 0);
        if (seq_start) {
#pragma unroll
            for (int e = 0; e < 8; ++e) { g2[e] = 0.f; g1[e] = 0.f; v2[e] = 0.f; v1_[e] = 0.f; }
        } else {
            const v4u a = *(const v4u*)(U + (size_t)(r0 - 2) * DFF2 + c), bq = *(const v4u*)(U + (size_t)(r0 - 1) * DFF2 + c);
            const v4u cq = *(const v4u*)(U + (size_t)(r0 - 2) * DFF2 + DFF + c), dq = *(const v4u*)(U + (size_t)(r0 - 1) * DFF2 + DFF + c);
            g2[0] = bflo(a.x); g2[1] = bfhi(a.x); g2[2] = bflo(a.y); g2[3] = bfhi(a.y); g2[4] = bflo(a.z); g2[5] = bfhi(a.z); g2[6] = bflo(a.w); g2[7] = bfhi(a.w);
            g1[0] = bflo(bq.x); g1[1] = bfhi(bq.x); g1[2] = bflo(bq.y); g1[3] = bfhi(bq.y); g1[4] = bflo(bq.z); g1[5] = bfhi(bq.z); g1[6] = bflo(bq.w); g1[7] = bfhi(bq.w);
            v2[0] = bflo(cq.x); v2[1] = bfhi(cq.x); v2[2] = bflo(cq.y); v2[3] = bfhi(cq.y); v2[4] = bflo(cq.z); v2[5] = bfhi(cq.z); v2[6] = bflo(cq.w); v2[7] = bfhi(cq.w);
            v1_[0] = bflo(dq.x); v1_[1] = bfhi(dq.x); v1_[2] = bflo(dq.y); v1_[3] = bfhi(dq.y); v1_[4] = bflo(dq.z); v1_[5] = bfhi(dq.z); v1_[6] = bflo(dq.w); v1_[7] = bfhi(dq.w);
        }
#pragma unroll
        for (int tt = 0; tt < 16; ++tt) {
            const v4u a = *(const v4u*)(U + (size_t)(r0 + tt) * DFF2 + c), cq = *(const v4u*)(U + (size_t)(r0 + tt) * DFF2 + DFF + c);
            float g0[8], v0[8];
            g0[0] = bflo(a.x); g0[1] = bfhi(a.x); g0[2] = bflo(a.y); g0[3] = bfhi(a.y); g0[4] = bflo(a.z); g0[5] = bfhi(a.z); g0[6] = bflo(a.w); g0[7] = bfhi(a.w);
            v0[0] = bflo(cq.x); v0[1] = bfhi(cq.x); v0[2] = bflo(cq.y); v0[3] = bfhi(cq.y); v0[4] = bflo(cq.z); v0[5] = bfhi(cq.z); v0[6] = bflo(cq.w); v0[7] = bfhi(cq.w);
            float o[8];
#pragma unroll
            for (int e = 0; e < 8; ++e) {
                const float ug = bg[e] + wg[0][e] * g2[e] + wg[1][e] * g1[e] + wg[2][e] * g0[e];
                const float uv = bv[e] + wv[0][e] * v2[e] + wv[1][e] * v1_[e] + wv[2][e] * v0[e];
                o[e] = gelu_tanh(ug) * uv; g2[e] = g1[e]; g1[e] = g0[e]; v2[e] = v1_[e]; v1_[e] = v0[e];
            }
            v4u ow; ow.x = pg8::cvt_pk_bf16(o[0], o[1]); ow.y = pg8::cvt_pk_bf16(o[2], o[3]); ow.z = pg8::cvt_pk_bf16(o[4], o[5]); ow.w = pg8::cvt_pk_bf16(o[6], o[7]);
            *(v4u*)(ACT + (size_t)(r0 + tt) * DFF + c) = ow;
        }
    }
}

struct GainNone { __device__ __forceinline__ float operator()(int) const { return 1.0f; } };
struct GainVec { const float* g; __device__ __forceinline__ float operator()(int k) const { return g[k]; } };
struct GainOut { const float* subln; const float* lnorm; float s; __device__ __forceinline__ float operator()(int k) const { return k < 1024 ? subln[k & 127] * s : lnorm[k - 1024]; } };
template <class GF>
__device__ __forceinline__ void tr_item(const float* W, int N, int K, bf16* WT, int dst_row0, int k0, int n0, const GF& gain, LAS float* scr, int lane) {
#pragma unroll 8
    for (int i = 0; i < 32; ++i) { const int kk = 2 * i + (lane >> 5); scr[kk * 33 + (lane & 31)] = W[(size_t)(k0 + kk) * N + n0 + (lane & 31)] * gain(k0 + kk); }
    LDS_WAIT(); asm volatile("" ::: "memory");
    const int c = lane & 7;
#pragma unroll
    for (int j = 0; j < 4; ++j) { const int n = (lane >> 3) + 8 * j; const LAS float* s = scr + (8 * c) * 33 + n;
        v4u o; o.x = pk2(s[0 * 33], s[1 * 33]); o.y = pk2(s[2 * 33], s[3 * 33]); o.z = pk2(s[4 * 33], s[5 * 33]); o.w = pk2(s[6 * 33], s[7 * 33]);
        *(GAS v4u*)(WT + (size_t)(dst_row0 + n) * K + k0 + 8 * c) = o; }
    LDS_WAIT(); asm volatile("" ::: "memory");
}
__device__ __forceinline__ int map_in(int n0) {
    const int sec = n0 >> 10, lc = n0 & 1023;
    if (sec < 2) { const int tt = lc >> 8, lb = (lc >> 5) & 7; return sec * 1024 + tt * 256 + (lb & 1) * 128 + (lb >> 1) * 32; }
    if (sec == 2) return 4096 + lc;
    return (sec - 1) * 1024 + lc;
}

struct Args { const void* in[24]; float* out; unsigned char* ws; };

__global__ void __launch_bounds__(NWAVES * 64, 2) mega_fwd(Args args) {
    extern __shared__ __attribute__((aligned(16))) unsigned char lds_raw[];
    LAS unsigned char* lds = (LAS unsigned char*)lds_raw;
    volatile LAS unsigned* MISC = (volatile LAS unsigned*)(lds + MISC_OFF);
    const int tid = threadIdx.x, lane = tid & 63; const int wave = __builtin_amdgcn_readfirstlane(tid >> 6);
    const int G = gridDim.x; int vcu; { const int bx = blockIdx.x; vcu = (G % 8 == 0) ? (bx % 8) * (G / 8) + bx / 8 : bx; }
    unsigned char* ws = args.ws;
    gu32* ctl = (gu32*)(ws + WS_CTL);
#define INP(T, i) ((const T*)ldptr(lds, (i)))
#define x_in INP(float, 0)
#define positions INP(int, 1)
#define attn_norm INP(float, 2)
#define w_in INP(float, 3)
#define lq1 INP(float, 4)
#define lk1 INP(float, 5)
#define lq2 INP(float, 6)
#define lk2 INP(float, 7)
#define subln INP(float, 8)
#define lru_conv_w INP(float, 9)
#define lru_conv_b INP(float, 10)
#define gate_a_w INP(float, 11)
#define gate_a_b INP(float, 12)
#define gate_x_w INP(float, 13)
#define gate_x_b INP(float, 14)
#define lru_lambda INP(float, 15)
#define lru_norm INP(float, 16)
#define w_out INP(float, 17)
#define mlp_norm INP(float, 18)
#define w_up INP(float, 19)
#define ffn_conv_w INP(float, 20)
#define ffn_conv_b INP(float, 21)
#define w_down INP(float, 22)
#define final_norm INP(float, 23)
#define X ((float*)ldptr(lds, 24))
#define WSB ((unsigned char*)ldptr(lds, 25))
#define WG ((bf16*)(WSB + WS_WG))
#define COS ((float*)(WSB + WS_COS))
#define SIN ((float*)(WSB + WS_SIN))
#define RSTD ((float*)(WSB + WS_RSTD))
#define SS ((float*)(WSB + WS_SS))
#define CHP ((float*)(WSB + WS_CHP))
#define CHH ((float*)(WSB + WS_CHH))
#define WIN ((bf16*)(WSB + WS_WIN))
#define WOUT ((bf16*)(WSB + WS_WOUT))
#define WUP ((bf16*)(WSB + WS_WUP))
#define WDN ((bf16*)(WSB + WS_WDN))
#define XB ((bf16*)(WSB + WS_XB))
#define Qb ((bf16*)(WSB + WS_Q))
#define Kb ((bf16*)(WSB + WS_K))
#define VT ((bf16*)(WSB + WS_VT))
#define XBR ((bf16*)(WSB + WS_XBR))
#define GBb ((bf16*)(WSB + WS_GB))
#define MIX ((bf16*)(WSB + WS_MIX))
#define HLOC ((float*)(WSB + WS_HLOC))
#define CUMA ((float*)(WSB + WS_CUMA))
#define STASH ((f32x4*)(WSB + WS_STASH))
#define Ub ((bf16*)(WSB + WS_U))
#define ACT ((bf16*)(WSB + WS_ACT))
    for (int u = tid; u < (LDS_BYTES - LDSCTL_OFF) / 4; u += NWAVES * 64) ((LAS unsigned*)(lds + LDSCTL_OFF))[u] = 0u;
    __syncthreads();
    { LAS unsigned long long* PT = (LAS unsigned long long*)(lds + PTR_OFF); if (tid < 24) PT[tid] = (unsigned long long)args.in[tid]; if (tid == 24) PT[24] = (unsigned long long)args.out; if (tid == 25) PT[25] = (unsigned long long)args.ws; }
    __syncthreads();
    XcdBarrier bar = xcd_barrier_post((unsigned*)(ctl + CW_BAR), MISC + 8);
#define GRID_BAR() xcd_barrier(bar)

#pragma unroll 1
    for (int rep = 0; rep < REP_PRO; ++rep) {
        LAS float* scr = (LAS float*)(lds + RING_OFF + wave * 16384);
        const int gw = vcu * NWAVES + wave, NGW = G * NWAVES;
        constexpr int I_IN = 32 * 160, I_OUT = 32 * 64, I_UP = 32 * 384, I_DN = 96 * 64, I_G = 128, I_L = I_IN + I_OUT + I_UP + I_DN + I_G;
#pragma unroll 1
        for (int it = gw; it < DEPTH * I_L; it += NGW) {
            const int l = it / I_L; int r = it - l * I_L;
            if (r < I_IN) { const int kb = r / 160, nb = r - kb * 160; tr_item(w_in + (size_t)l * DM * INW, INW, DM, WIN + (size_t)l * INW * DM, map_in(32 * nb), 64 * kb, 32 * nb, GainVec{attn_norm + l * DM}, scr, lane); continue; } r -= I_IN;
            if (r < I_OUT) { const int kb = r / 64, nb = r - kb * 64; const float li = 0.8f - 0.6f * expf(-0.3f * (float)l);
                tr_item(w_out + (size_t)l * DM * DM, DM, DM, WOUT + (size_t)l * DM * DM, 32 * nb, 64 * kb, 32 * nb, GainOut{subln + l * VD, lru_norm + l * LW, 1.0f - li}, scr, lane); continue; } r -= I_OUT;
            if (r < I_UP) { const int kb = r / 384, nb = r - kb * 384; tr_item(w_up + (size_t)l * DM * DFF2, DFF2, DM, WUP + (size_t)l * DFF2 * DM, 32 * nb, 64 * kb, 32 * nb, GainVec{mlp_norm + l * DM}, scr, lane); continue; } r -= I_UP;
            if (r < I_DN) { const int kb = r / 64, nb = r - kb * 64; tr_item(w_down + (size_t)l * DFF * DM, DM, DFF, WDN + (size_t)l * DM * DFF, 32 * nb, 64 * kb, 32 * nb, GainNone{}, scr, lane); continue; } r -= I_DN;
            { const int mat = r >> 3, sub = r & 7; const int hb = mat >> 1, g = mat & 1; const int kb = sub >> 2, nb = sub & 3;
              const float* src = (g == 0 ? gate_a_w : gate_x_w) + ((size_t)l * NLB + hb) * LBLK * LBLK;
              tr_item(src, LBLK, LBLK, WG + (((size_t)l * NLB + hb) * 2 + g) * LBLK * LBLK, 32 * nb, 64 * kb, 32 * nb, GainNone{}, scr, lane); }
        }
#pragma unroll 1
        for (int id = vcu * 512 + tid; id < M * 32; id += G * 512) {
            const int row = id >> 5, i = id & 31;
            const float inv = 1.0f / powf(10000.0f, (float)(2 * i) * (1.0f / 64.0f));
            const float ang = (float)positions[row] * inv; float sv, cv; sincosf(ang, &sv, &cv);
            COS[id] = cv; SIN[id] = sv;
        }
#pragma unroll 1
        for (int row = gw; row < M; row += NGW) {
            const GAS f32x4* xr = (const GAS f32x4*)(x_in + (size_t)row * DM) + lane; float s = 0.f; f32x4 v[8];
#pragma unroll
            for (int j = 0; j < 8; ++j) { v[j] = xr[64 * j]; s += (v[j][0] * v[j][0] + v[j][1] * v[j][1]) + (v[j][2] * v[j][2] + v[j][3] * v[j][3]); }
            s = wave_sum(s);
            if (lane == 0) RSTD[row] = 1.0f / sqrtf(s * (1.0f / DM) + EPS);
            GAS u32x2* o8 = (GAS u32x2*)(XB + (size_t)row * DM) + lane;
#pragma unroll
            for (int j = 0; j < 8; ++j) { u32x2 o; o.x = pk2(v[j][0], v[j][1]); o.y = pk2(v[j][2], v[j][3]); o8[64 * j] = o; }
        }
    }
    GRID_BAR();

#pragma unroll 1
    for (int l = 0; l < DEPTH; ++l) {
        const float lam_init = 0.8f - 0.6f * expf(-0.3f * (float)l);
#pragma unroll 1
        for (int rep = 0; rep < REP_P1; ++rep) {
        {
            pg8::Gemm g{XB, WIN + (size_t)l * INW * DM, M, 4096, DM}; pg8::StaticOrder S; S.init(M, 4096, G, (int)blockIdx.x);
            EpiInProj E{RSTD, COS, SIN, Qb, Kb, XBR, GBb};
            pg8::gemm_phase<EpiInProj, pg8::StaticOrder, true, true>(lds + RING_OFF, g, S, E);
        }
        {
            pg8::Gemm g{WIN + (size_t)l * INW * DM + (size_t)4096 * DM, XB, 1024, M, DM}; pg8::StaticOrder S; S.init(1024, M, G, (int)blockIdx.x);
            EpiVt E{RSTD, VT};
            pg8::gemm_phase<EpiVt, pg8::StaticOrder, true, true>(lds + RING_OFF, g, S, E);
        }
        }
        GRID_BAR();
        {
            float lam;
            { const float a = lq1[l * QKD + lane] * lk1[l * QKD + lane], bq = lq2[l * QKD + lane] * lk2[l * QKD + lane];
              lam = expf(wave_sum(a)) - expf(wave_sum(bq)) + lam_init; }
#pragma unroll 1
            for (int i4 = 0; i4 < 4 * REP_ATTN; ++i4) { const int i = i4 & 3;
                const int pidx = vcu + G * (i >> 1);
                if (pidx < BATCH * NHEAD * 8) {
                    const int bh = pidx >> 3, s = pidx & 7; const int qb = (i & 1) ? 15 - s : s;
                    attn_unit(lds, Qb, Kb, VT, MIX, STASH + ((size_t)blockIdx.x * 4 + i) * (8 * 16 * 64), bh >> 3, bh & 7, qb, lam);
                }
            }
#pragma unroll 1
            for (int uu = vcu; uu < BATCH * NCH * NLB * REP_LRUL; uu += G) { const int uidx = uu & (BATCH * NCH * NLB - 1);
                const int hb = uidx & 7, ck = (uidx >> 3) & (NCH - 1), b = uidx >> 9;
                lru_local_unit(lds, XBR, lru_conv_w + (size_t)l * 4 * LW, lru_conv_b + (size_t)l * LW, WG + (size_t)l * NLB * 2 * LBLK * LBLK, gate_a_b + (size_t)l * LW, gate_x_b + (size_t)l * LW,
                               lru_lambda + (size_t)l * LW, HLOC, CUMA, CHP, CHH, b, ck, hb);
            }
        }
        GRID_BAR();
#pragma unroll 1
        for (int uu = vcu; uu < BATCH * NCH * REP_LRUF; uu += G) { const int uidx = uu & (BATCH * NCH - 1); lru_fix_unit(lds, HLOC, CUMA, CHP, CHH, GBb, MIX, uidx >> 6, uidx & (NCH - 1)); }
        GRID_BAR();
#pragma unroll 1
        for (int rep = 0; rep < REP_P4; ++rep) {
            pg8::Gemm g{MIX, WOUT + (size_t)l * DM * DM, M, DM, DM}; pg8::StaticOrder S; S.init(M, DM, G, (int)blockIdx.x);
            EpiResid E{l == 0 ? x_in : X, rep == 0 ? X : (float*)(WSB + WS_HLOC), rep == 0 ? XB : (bf16*)(WSB + WS_STASH), rep == 0 ? SS : (float*)(WSB + WS_CHP), 0};
            pg8::gemm_phase<EpiResid, pg8::StaticOrder, true, true>(lds + RING_OFF, g, S, E);
        }
        GRID_BAR();
#pragma unroll 1
        for (int id = vcu * 512 + tid; id < M * 4; id += G * 512) {
            const int row = id >> 2, part = id & 3; const f32x4 a = *(const f32x4*)(SS + (size_t)row * 32 + part * 8), bq = *(const f32x4*)(SS + (size_t)row * 32 + part * 8 + 4);
            float s = (a[0] + a[1]) + (a[2] + a[3]) + (bq[0] + bq[1]) + (bq[2] + bq[3]); s += __shfl_xor(s, 1); s += __shfl_xor(s, 2);
            if (part == 0) RSTD[row] = 1.0f / sqrtf(s * (1.0f / DM) + EPS);
        }
        GRID_BAR();
#pragma unroll 1
        for (int hf = 0; hf < 2; ++hf) {
#pragma unroll 1
            for (int rep = 0; rep < REP_UP; ++rep) {
                pg8::Gemm g{XB + (size_t)hf * MH * DM, WUP + (size_t)l * DFF2 * DM, MH, DFF2, DM}; pg8::StaticOrder S; S.init(MH, DFF2, G, (int)blockIdx.x);
                EpiUp E{RSTD + hf * MH, Ub};
                pg8::gemm_phase<EpiUp, pg8::StaticOrder, true, true>(lds + RING_OFF, g, S, E);
            }
            GRID_BAR();
#pragma unroll 1
            for (int rep = 0; rep < REP_FFNC; ++rep)
            ffn_conv_phase(Ub, ACT + (size_t)hf * MH * DFF, ffn_conv_w + (size_t)l * 3 * DFF2, ffn_conv_b + (size_t)l * DFF2, vcu, G, tid);
            GRID_BAR();
        }
#pragma unroll 1
        for (int rep = 0; rep < REP_P7; ++rep) {
            pg8::Gemm g{ACT, WDN + (size_t)l * DM * DFF, M, DM, DFF}; pg8::StaticOrder S; S.init(M, DM, G, (int)blockIdx.x);
            EpiResid E{X, rep == 0 ? X : (float*)(WSB + WS_Q), rep == 0 ? XB : (bf16*)(WSB + WS_Q + 256 * MiB), rep == 0 ? SS : (float*)(WSB + WS_CHP), 0};
            pg8::gemm_phase<EpiResid, pg8::StaticOrder, true, true>(lds + RING_OFF, g, S, E);
        }
        GRID_BAR();
        if (l + 1 < DEPTH) {
#pragma unroll 1
            for (int id = vcu * 512 + tid; id < M * 4; id += G * 512) {
                const int row = id >> 2, part = id & 3; const f32x4 a = *(const f32x4*)(SS + (size_t)row * 32 + part * 8), bq = *(const f32x4*)(SS + (size_t)row * 32 + part * 8 + 4);
                float s = (a[0] + a[1]) + (a[2] + a[3]) + (bq[0] + bq[1]) + (bq[2] + bq[3]); s += __shfl_xor(s, 1); s += __shfl_xor(s, 2);
                if (part == 0) RSTD[row] = 1.0f / sqrtf(s * (1.0f / DM) + EPS);
            }
            GRID_BAR();
        }
    }
    {
        const int gw = vcu * NWAVES + wave, NGW = G * NWAVES;
        const unsigned bad = __hip_atomic_load((gu32*)(ctl + CW_BAR + XB_TMO), RLX_AGENT);
#pragma unroll 1
        for (int row = gw; row < M; row += NGW) {
            GAS f32x4* xr = (GAS f32x4*)(X + (size_t)row * DM) + lane; float s = 0.f; f32x4 v[8];
#pragma unroll
            for (int j = 0; j < 8; ++j) { v[j] = xr[64 * j]; s += (v[j][0] * v[j][0] + v[j][1] * v[j][1]) + (v[j][2] * v[j][2] + v[j][3] * v[j][3]); }
            s = wave_sum(s); float rn = 1.0f / sqrtf(s * (1.0f / DM) + EPS); if (bad) rn = __builtin_nanf("");
#pragma unroll
            for (int j = 0; j < 8; ++j) { const f32x4 gg = *(const f32x4*)(final_norm + 256 * j + 4 * lane); xr[64 * j] = v[j] * rn * gg; }
        }
    }
}

extern "C" void kernel_launch(void* const* d_in, const int* in_sizes, int n_in, void* d_out, int out_size, void* d_ws, size_t ws_size, hipStream_t stream) {
    static int grid = 0;
    if (grid == 0) {
        if (n_in != 24 || in_sizes[0] != M * DM || out_size != M * DM || ws_size < WS_END) {
            fprintf(stderr, "kernel_launch: shape/workspace mismatch: n_in %d in0 %d out %d ws %zu (need %zu)\n", n_in, n_in > 0 ? in_sizes[0] : -1, out_size, ws_size, (size_t)WS_END); grid = -1; return; }
        int dev = 0, cus = 0, per_cu = 0;
        if (hipGetDevice(&dev) != hipSuccess || hipDeviceGetAttribute(&cus, hipDeviceAttributeMultiprocessorCount, dev) != hipSuccess) { fprintf(stderr, "kernel_launch: device query failed\n"); grid = -1; return; }
        if (hipFuncSetAttribute((const void*)mega_fwd, hipFuncAttributeMaxDynamicSharedMemorySize, LDS_BYTES) != hipSuccess) { fprintf(stderr, "kernel_launch: hipFuncSetAttribute failed\n"); grid = -1; return; }
        if (hipOccupancyMaxActiveBlocksPerMultiprocessor(&per_cu, (const void*)mega_fwd, NWAVES * 64, LDS_BYTES) != hipSuccess || per_cu < 1) { fprintf(stderr, "kernel_launch: occupancy query reports %d blocks per CU\n", per_cu); (void)hipGetLastError(); if (per_cu < 1) { grid = -1; return; } }
        grid = cus;
    }
    if (grid < 0) return;
    if (hipMemsetAsync((char*)d_ws + WS_CTL, 0, CTL_ZERO_BYTES, stream) != hipSuccess) { fprintf(stderr, "kernel_launch: memset failed\n"); return; }
    Args a{};
    for (int i = 0; i < 24; ++i) a.in[i] = d_in[i];
    a.out = (float*)d_out; a.ws = (unsigned char*)d_ws;
    hipLaunchKernelGGL(mega_fwd, dim3(grid), dim3(NWAVES * 64), LDS_BYTES, stream, a);
    const hipError_t le = hipPeekAtLastError();
    if (le != hipSuccess) fprintf(stderr, "kernel_launch: launch failed: %s\n", hipGetErrorName(le));
}
```

```cpp
#include <hip/hip_runtime.h>
#include <cstdio>
#include <cstdint>
namespace pg8 {
#define PG8_LAS __attribute__((address_space(3)))
typedef unsigned short bf16_t;
typedef short bf16x8 __attribute__((ext_vector_type(8)));
typedef float f32x4 __attribute__((ext_vector_type(4)));
typedef unsigned u32x4 __attribute__((ext_vector_type(4)));
constexpr int BM = 256, BK = 64, HALF = 128, HTB = HALF * BK * 2  , STAGE_BYTES = 8 * HTB, NXCD = 8, WGM = 8;

__host__ __device__ __forceinline__ int lds_byte(int r, int c) { const int st = (r >> 4) * 2 + (c >> 5), rr = r & 15, cc = c & 31, ob = rr * 64 + cc * 2; return st * 1024 + (ob ^ (((ob >> 9) & 1) << 5)); }
__host__ __device__ __forceinline__ void stage_rc(int b, int& R, int& C) { const int st = b / 1024, sb = b % 1024, swz = sb ^ (((sb >> 9) & 1) << 5); R = (st >> 1) * 16 + swz / 64; C = (st & 1) * 32 + (swz % 64) / 2; }
__host__ __device__ __forceinline__ int perm32(int rho) { const int n = rho >> 4, i = rho & 15; return 8 * (i >> 2) + 4 * n + (i & 3); }

struct Unit { int pm, pn; };
struct Gemm { const bf16_t* A; const bf16_t* Bt; int M, N, K; };

struct StaticOrder {
    int nM, nN, nwg, G, c;
    __host__ __device__ void init(int M, int N, int G_, int c_) { nM = M / BM; nN = N / BM; nwg = nM * nN; G = G_; c = c_; }
    __host__ __device__ bool next(int i, Unit& u) const {
        const long L = (long)i * G + c; if (L >= nwg) return false;
        int wgid = (int)L; { const int q = nwg / NXCD, r = nwg % NXCD, xcd = wgid % NXCD, off = wgid / NXCD; wgid = (xcd < r ? xcd * (q + 1) : r * (q + 1) + (xcd - r) * q) + off; }
        const int nig = WGM * nN, gid = wgid / nig, fm = gid * WGM, gsz = (nM - fm) < WGM ? (nM - fm) : WGM;
        u.pm = fm + ((wgid % nig) % gsz); u.pn = (wgid % nig) / gsz; return true;
    }
    __device__ __forceinline__ void a_ready(const Unit&) const {}
    __device__ __forceinline__ void done(const Unit&) const {}
};

__device__ __forceinline__ unsigned cvt_pk_bf16(float lo, float hi) { unsigned r; asm volatile("v_cvt_pk_bf16_f32 %0, %1, %2" : "=v"(r) : "v"(lo), "v"(hi)); return r; }
typedef float f32x2 __attribute__((ext_vector_type(2)));
template <class Epi, class Sched, bool ALIGN_EPI = false, bool SP2 = false>
__device__ __forceinline__ void gemm_phase(PG8_LAS unsigned char* lds, const Gemm g, const Sched& S, const Epi& E) {
    int tid_ = threadIdx.x; asm volatile("" : "+v"(tid_));
    const int tid = tid_, wid = __builtin_amdgcn_readfirstlane(tid >> 6), lane = tid & 63, wr = wid >> 2, wc = wid & 3, fr = lane & 15, fq = lane >> 4;
    const int K = g.K, nt = K / BK;
    unsigned voffA[2], voffB[2];
#pragma unroll
    for (int i = 0; i < 2; ++i) { int R, C; stage_rc(tid * 16 + i * 8192, R, C); const int Rb = Epi::PERM ? ((R & ~31) + perm32(R & 31)) : R;
        voffA[i] = (unsigned)(R * K + C) * 2u; voffB[i] = (unsigned)(Rb * K + C) * 2u; }
    const size_t kstep = (size_t)(BK * 2);
    const size_t hstep = (size_t)HALF * K * 2;
    const size_t tstep = 2 * hstep;
    const unsigned ldsw = (unsigned)wid * 1024u;
    const int aoff = lds_byte(wr * 64 + fr, fq * 8), boff = lds_byte(wc * 32 + fr, fq * 8);
#define PG8_SA(b, h) (((b) * 2 + (h)) * HTB)
#define PG8_SB(b, h) ((4 + (b) * 2 + (h)) * HTB)
#define PG8_STAGE(bufoff, gbase, voff) do { _Pragma("unroll") for (int _i = 0; _i < 2; ++_i) \
        __builtin_amdgcn_global_load_lds((const unsigned*)((const char*)(gbase) + (voff)[_i]), (PG8_LAS unsigned*)(lds + (bufoff) + ldsw + _i * 8192), 16, 0, 0); } while (0)
#define PG8_LDA(dst, b, h) do { _Pragma("unroll") for (int m = 0; m < 4; ++m) _Pragma("unroll") for (int k = 0; k < 2; ++k) dst[m][k] = *(const PG8_LAS bf16x8*)(lds + PG8_SA(b, h) + aoff + m * 2048 + k * 1024); } while (0)
#define PG8_LDB(dst, b, h) do { _Pragma("unroll") for (int n = 0; n < 2; ++n) _Pragma("unroll") for (int k = 0; k < 2; ++k) dst[n][k] = *(const PG8_LAS bf16x8*)(lds + PG8_SB(b, h) + boff + n * 2048 + k * 1024); } while (0)
#define PG8_MMA(ai, bj, At, Bt) do { __builtin_amdgcn_s_setprio(1); _Pragma("unroll") for (int m = 0; m < 4; ++m) _Pragma("unroll") for (int n = 0; n < 2; ++n) _Pragma("unroll") for (int k = 0; k < 2; ++k) \
        acc[ai][bj][m][n] = __builtin_amdgcn_mfma_f32_16x16x32_bf16(Bt[n][k], At[m][k], acc[ai][bj][m][n], 0, 0, 0); __builtin_amdgcn_s_setprio(0); } while (0)
#define PG8_WAIT_V(n) asm volatile("s_waitcnt vmcnt(" #n ")" ::: "memory")
#define PG8_WAIT_L(n) asm volatile("s_waitcnt lgkmcnt(" #n ")" ::: "memory")
#define PG8_BAR __builtin_amdgcn_s_barrier()
#define PG8_SCHED __builtin_amdgcn_sched_barrier(0)
    Unit cur, nxt; int ui = 0;
    if (!S.next(0, cur)) return;
    f32x4 acc[2][2][4][2];
#pragma unroll
    for (int a = 0; a < 2; ++a)
#pragma unroll
        for (int b = 0; b < 2; ++b)
#pragma unroll
            for (int m = 0; m < 4; ++m)
#pragma unroll
                for (int n = 0; n < 2; ++n) acc[a][b][m][n] = (f32x4){0.f, 0.f, 0.f, 0.f};
    bf16x8 At[4][2], B0[2][2], B1[2][2];
    const char* cA = (const char*)g.A + (size_t)cur.pm * tstep; const char* cB = (const char*)g.Bt + (size_t)cur.pn * tstep;
    S.a_ready(cur);
    if constexpr (SP2) {
        PG8_STAGE(PG8_SB(0, 0), cB, voffB); PG8_STAGE(PG8_SB(0, 1), cB + hstep, voffB); PG8_STAGE(PG8_SA(0, 0), cA, voffA); PG8_STAGE(PG8_SA(0, 1), cA + hstep, voffA);
        if (wr == 1) PG8_BAR;
        PG8_WAIT_V(2); PG8_BAR;
        PG8_STAGE(PG8_SB(1, 0), cB + kstep, voffB); PG8_STAGE(PG8_SA(1, 0), cA + kstep, voffA); PG8_STAGE(PG8_SB(1, 1), cB + hstep + kstep, voffB);
        PG8_WAIT_V(6); PG8_BAR;
    } else {
        PG8_STAGE(PG8_SB(0, 0), cB, voffB); PG8_STAGE(PG8_SA(0, 0), cA, voffA); PG8_STAGE(PG8_SB(0, 1), cB + hstep, voffB); PG8_STAGE(PG8_SA(0, 1), cA + hstep, voffA);
        if (wr == 1) PG8_BAR;
        PG8_WAIT_V(4); PG8_BAR;
        PG8_STAGE(PG8_SB(1, 0), cB + kstep, voffB); PG8_STAGE(PG8_SA(1, 0), cA + kstep, voffA); PG8_STAGE(PG8_SB(1, 1), cB + hstep + kstep, voffB);
        PG8_WAIT_V(6); PG8_BAR;
    }
    for (;;) {
        const bool has_next = S.next(ui + 1, nxt);
        const char* nA = has_next ? (const char*)g.A + (size_t)nxt.pm * tstep : cA; const char* nB = has_next ? (const char*)g.Bt + (size_t)nxt.pn * tstep : cB;
        for (int t = 0; t < nt; t += 2) {
            const bool last = (t == nt - 2);
            const char* a1 = cA + (size_t)(t + 1) * kstep;
            const char* a2 = last ? nA : cA + (size_t)(t + 2) * kstep; const char* b2 = last ? nB : cB + (size_t)(t + 2) * kstep;
            const char* a3 = a2 + kstep; const char* b3 = b2 + kstep;
            if (last && has_next) S.a_ready(nxt);
            if constexpr (SP2) {
            PG8_LDB(B0, 0, 0); PG8_LDB(B1, 0, 1); PG8_SCHED; PG8_LDA(At, 0, 0); PG8_STAGE(PG8_SA(1, 1), a1 + hstep, voffA);
            PG8_WAIT_V(8); PG8_WAIT_L(0); PG8_BAR; PG8_MMA(0, 0, At, B0); PG8_MMA(0, 1, At, B1); PG8_BAR; PG8_SCHED;
            PG8_LDA(At, 0, 1); PG8_STAGE(PG8_SB(0, 0), b2, voffB); PG8_STAGE(PG8_SB(0, 1), b2 + hstep, voffB); PG8_STAGE(PG8_SA(0, 0), a2, voffA);
            PG8_WAIT_V(8); PG8_WAIT_L(0); PG8_BAR; PG8_MMA(1, 0, At, B0); PG8_MMA(1, 1, At, B1); PG8_BAR; PG8_SCHED;
            PG8_LDB(B0, 1, 0); PG8_LDB(B1, 1, 1); PG8_SCHED; PG8_LDA(At, 1, 0); PG8_STAGE(PG8_SA(0, 1), a2 + hstep, voffA);
            PG8_WAIT_V(8); PG8_WAIT_L(0); PG8_BAR; PG8_MMA(0, 0, At, B0); PG8_MMA(0, 1, At, B1); PG8_BAR; PG8_SCHED;
            PG8_LDA(At, 1, 1); PG8_STAGE(PG8_SB(1, 0), b3, voffB); PG8_STAGE(PG8_SB(1, 1), b3 + hstep, voffB); PG8_STAGE(PG8_SA(1, 0), a3, voffA);
            PG8_WAIT_V(8); PG8_WAIT_L(0); PG8_BAR; PG8_MMA(1, 0, At, B0); PG8_MMA(1, 1, At, B1); PG8_BAR; PG8_SCHED;
            } else {
            PG8_LDB(B0, 0, 0); PG8_SCHED; PG8_LDA(At, 0, 0); PG8_STAGE(PG8_SA(1, 1), a1 + hstep, voffA);
            PG8_WAIT_L(8); PG8_BAR; PG8_WAIT_L(0); PG8_MMA(0, 0, At, B0); PG8_BAR; PG8_SCHED;
            PG8_LDB(B1, 0, 1); PG8_STAGE(PG8_SB(0, 0), b2, voffB);
            PG8_BAR; PG8_WAIT_L(0); PG8_MMA(0, 1, At, B1); PG8_BAR;
            PG8_LDA(At, 0, 1); PG8_STAGE(PG8_SA(0, 0), a2, voffA);
            PG8_BAR; PG8_WAIT_L(0); PG8_MMA(1, 0, At, B0); PG8_BAR; PG8_SCHED;
            PG8_STAGE(PG8_SB(0, 1), b2 + hstep, voffB);
            PG8_WAIT_V(6); PG8_BAR; PG8_MMA(1, 1, At, B1); PG8_BAR;
            PG8_LDB(B0, 1, 0); PG8_SCHED; PG8_LDA(At, 1, 0); PG8_STAGE(PG8_SA(0, 1), a2 + hstep, voffA);
            PG8_WAIT_L(8); PG8_BAR; PG8_WAIT_L(0); PG8_MMA(0, 0, At, B0); PG8_BAR; PG8_SCHED;
            PG8_LDB(B1, 1, 1); PG8_STAGE(PG8_SB(1, 0), b3, voffB);
            PG8_BAR; PG8_WAIT_L(0); PG8_MMA(0, 1, At, B1); PG8_BAR;
            PG8_LDA(At, 1, 1); PG8_STAGE(PG8_SA(1, 0), a3, voffA);
            PG8_BAR; PG8_WAIT_L(0); PG8_MMA(1, 0, At, B0); PG8_BAR; PG8_SCHED;
            PG8_STAGE(PG8_SB(1, 1), b3 + hstep, voffB);
            PG8_WAIT_V(6); PG8_BAR; PG8_MMA(1, 1, At, B1); PG8_BAR;
            }
        }
        if constexpr (ALIGN_EPI) { if (wr == 0) PG8_BAR; }
        if constexpr (!Epi::AFTER_DRAIN) { E(acc, cur, wr, wc, fr, fq); S.done(cur); }
        if (!has_next) break;
#pragma unroll
        for (int a = 0; a < 2; ++a)
#pragma unroll
            for (int b = 0; b < 2; ++b)
#pragma unroll
                for (int m = 0; m < 4; ++m)
#pragma unroll
                    for (int n = 0; n < 2; ++n) acc[a][b][m][n] = (f32x4){0.f, 0.f, 0.f, 0.f};
        cur = nxt; cA = nA; cB = nB; ++ui;
        if constexpr (ALIGN_EPI) { if (wr == 1) PG8_BAR; }
    }
    PG8_WAIT_V(0);
    if constexpr (!ALIGN_EPI) { if (wr == 0) PG8_BAR; }
    PG8_BAR;
    if constexpr (Epi::AFTER_DRAIN) { E.fused(acc, cur, wr, wc, fr, fq, lds, wid, lane); S.done(cur); }
#undef PG8_SA
#undef PG8_SB
#undef PG8_STAGE
#undef PG8_LDA
#undef PG8_LDB
#undef PG8_MMA
#undef PG8_WAIT_V
#undef PG8_WAIT_L
#undef PG8_BAR
#undef PG8_SCHED
}
}
#define GAS __attribute__((address_space(1)))
#define LAS __attribute__((address_space(3)))
typedef unsigned short bf16;
typedef unsigned v4u __attribute__((ext_vector_type(4)));
typedef float f32x4 __attribute__((ext_vector_type(4)));
typedef short bf16x8 __attribute__((ext_vector_type(8)));
typedef GAS unsigned gu32;
typedef GAS unsigned long long gu64;
#define RLX_AGENT __ATOMIC_RELAXED, __HIP_MEMORY_SCOPE_AGENT
#define LDS_WAIT() asm volatile("s_waitcnt lgkmcnt(0)" ::: "memory")
#define VM_WAIT() asm volatile("s_waitcnt vmcnt(0)" ::: "memory")
__device__ __forceinline__ unsigned long long rt() { return __builtin_amdgcn_s_memrealtime(); }
__device__ __forceinline__ unsigned f2bf(float f) { unsigned u = __builtin_bit_cast(unsigned, f); return (u + 0x7fffu + ((u >> 16) & 1u)) >> 16; }
__device__ __forceinline__ unsigned pk2(float lo, float hi) { return f2bf(lo) | (f2bf(hi) << 16); }
typedef float f32x2v_t __attribute__((ext_vector_type(2)));
#define XB_TMO      128
#define XB_XCNT(j)  (256  + 64 * (j))
#define XB_XSUB(j)  (1280 + 64 * (j))
#define XB_XGEN(j)  (2304 + 64 * (j))
#define XB_TOP      3328
#define XB_TOPGEN   3392
#define XCD_BAR_WORDS 3456
#define XB_SPIN_CAP (1u << 18)

__device__ __forceinline__ unsigned xb_ld(unsigned* p)              { return __hip_atomic_load(p, __ATOMIC_RELAXED, __HIP_MEMORY_SCOPE_AGENT); }
__device__ __forceinline__ unsigned xb_add(unsigned* p, unsigned v) { return __hip_atomic_fetch_add(p, v, __ATOMIC_RELAXED, __HIP_MEMORY_SCOPE_AGENT); }
__device__ __forceinline__ unsigned xb_xcc_id() { return (unsigned)__builtin_amdgcn_s_getreg((3 << 11) | 20) & 0xFu; }
#define XB_SPIN(cond, bar) do { unsigned _sp = 0; while (cond) { __builtin_amdgcn_s_sleep(1); \
    if ((++_sp & 255u) == 0u) { if (xb_ld(&(bar)[XB_TMO])) break; if (_sp > XB_SPIN_CAP) { atomicAdd(&(bar)[XB_TMO], 1u); break; } } } } while (0)

struct XcdBarrier {
    unsigned* bar; unsigned x;
    volatile LAS unsigned* st;
};

__device__ __forceinline__ XcdBarrier xcd_barrier_post(unsigned* bar, volatile LAS unsigned* st) {
    XcdBarrier b; b.bar = bar; b.x = xb_xcc_id(); b.st = st;
    if (threadIdx.x == 0) (void)xb_add(&bar[XB_XCNT(b.x)], 1u);
    return b;
}
__device__ __forceinline__ void xcd_barrier_complete(unsigned* bar, unsigned x, unsigned& nloc, unsigned& nx) {
    const unsigned G = gridDim.x * gridDim.y * gridDim.z;
    unsigned sum, cnt, mine, sp = 0u;
    for (;;) {
        sum = 0u; cnt = 0u; mine = 0u;
#pragma unroll
        for (unsigned j = 0; j < 16; ++j) { const unsigned c = xb_ld(&bar[XB_XCNT(j)]); sum += c; cnt += (c > 0u) ? 1u : 0u; mine = (j == x) ? c : mine; }
        if (sum == G) break;
        __builtin_amdgcn_s_sleep(1);
        if ((++sp & 255u) == 0u) { if (xb_ld(&bar[XB_TMO])) break; if (sp > XB_SPIN_CAP) { atomicAdd(&bar[XB_TMO], 1u); break; } }
    }
    nloc = mine > 0u ? mine : 1u; nx = cnt > 0u ? cnt : 1u;
}

__device__ __forceinline__ void xcd_barrier(const XcdBarrier& b) {
    asm volatile("s_waitcnt vmcnt(0)" ::: "memory");
    __syncthreads();
    if (threadIdx.x == 0) {
        unsigned* bar = b.bar;
        __builtin_amdgcn_s_waitcnt(0);
        unsigned nloc = b.st[0], nx = b.st[1];
        if (nloc == 0u) { xcd_barrier_complete(bar, b.x, nloc, nx); b.st[0] = nloc; b.st[1] = nx; }
        const unsigned old = xb_add(&bar[XB_XSUB(b.x)], 1u);
        const unsigned gen = old / nloc;
        if (old + 1u == (gen + 1u) * nloc) {
            __builtin_amdgcn_fence(__ATOMIC_RELEASE, "agent");
            asm volatile("s_waitcnt vmcnt(0)" ::: "memory");
            const unsigned og = xb_add(&bar[XB_TOP], 1u);
            const unsigned tg = og / nx;
            if (og + 1u == (tg + 1u) * nx) xb_add(&bar[XB_TOPGEN], 1u);
            else XB_SPIN(xb_ld(&bar[XB_TOPGEN]) == tg, bar);
            __builtin_amdgcn_fence(__ATOMIC_ACQUIRE, "agent");
            xb_add(&bar[XB_XGEN(b.x)], 1u);
            asm volatile("s_waitcnt vmcnt(0)" ::: "memory");
        } else {
            XB_SPIN(xb_ld(&bar[XB_XGEN(b.x)]) == gen, bar);
            __builtin_amdgcn_fence(__ATOMIC_ACQUIRE, "agent");
            asm volatile("s_waitcnt vmcnt(0)" ::: "memory");
        }
    }
    __syncthreads();
}

constexpr int NWAVES = 8;
constexpr int BATCH = 8, SEQ = 4096, DM = 2048, DEPTH = 4;
constexpr int M = BATCH * SEQ;
constexpr int NHEAD = 8, QKD = 64, VD = 128;
constexpr int QKW = 1024, AW = 1024, LW = 1024, INW = 5120, DFF = 6144, DFF2 = 12288;
constexpr int LBLK = 128, NLB = 8;
constexpr int MH = M / 2;
constexpr float EPS = 1e-6f;
constexpr float C2 = 0.125f * 1.4426950408889634f;
constexpr int LCH = 64, NCH = SEQ / LCH;

constexpr size_t MiB = 1u << 20;
constexpr size_t WS_CTL = 0, CTL_ZERO_BYTES = 1 * MiB;
constexpr size_t WS_WG = 1 * MiB;
constexpr size_t WS_COS = 3 * MiB, WS_SIN = 7 * MiB;
constexpr size_t WS_RSTD = 11 * MiB;
constexpr size_t WS_SS = 12 * MiB;
constexpr size_t WS_CHP = 16 * MiB, WS_CHH = 18 * MiB;
constexpr size_t WS_WIN = 20 * MiB;
constexpr size_t WS_WOUT = 100 * MiB;
constexpr size_t WS_WUP = 132 * MiB;
constexpr size_t WS_WDN = 324 * MiB;
constexpr size_t WS_XB = 420 * MiB;
constexpr size_t WS_Q = 548 * MiB, WS_K = 612 * MiB, WS_VT = 676 * MiB, WS_XBR = 740 * MiB, WS_GB = 804 * MiB;
constexpr size_t WS_MIX = 868 * MiB;
constexpr size_t WS_HLOC = 996 * MiB, WS_CUMA = 1124 * MiB;
constexpr size_t WS_STASH = 1252 * MiB;
constexpr size_t WS_U = 548 * MiB;
constexpr size_t WS_ACT = 932 * MiB;
constexpr size_t WS_END = 1380 * MiB;
constexpr int CW_BAR = 4096;

constexpr int RING_OFF = 0, RING_BYTES = 131072;
constexpr int LDSCTL_OFF = RING_BYTES, MISC_OFF = LDSCTL_OFF + 320;
constexpr int LDS_BYTES = 147456;
constexpr int PTR_OFF = LDSCTL_OFF + 1024;
#ifndef REP_P1
#define REP_P1 1
#endif
#ifndef REP_ATTN
#define REP_ATTN 1
#endif
#ifndef REP_LRUL
#define REP_LRUL 1
#endif
#ifndef REP_LRUF
#define REP_LRUF 1
#endif
#ifndef REP_UP
#define REP_UP 1
#endif
#ifndef REP_FFNC
#define REP_FFNC 1
#endif
#ifndef REP_P4
#define REP_P4 1
#endif
#ifndef REP_P7
#define REP_P7 1
#endif
#ifndef REP_PRO
#define REP_PRO 1
#endif

typedef float f32x16 __attribute__((ext_vector_type(16)));
typedef unsigned u32x2 __attribute__((ext_vector_type(2)));
typedef const LAS unsigned char* lds_cp;

__device__ __forceinline__ float wave_sum(float v) {
#pragma unroll
    for (int o = 1; o < 64; o <<= 1) v += __shfl_xor(v, o);
    return v;
}
__device__ __forceinline__ float bf2f(unsigned short h) { return __uint_as_float(((unsigned)h) << 16); }
__device__ __forceinline__ float bflo(unsigned w) { return __uint_as_float(w << 16); }
__device__ __forceinline__ float bfhi(unsigned w) { return __uint_as_float(w & 0xffff0000u); }
__device__ __forceinline__ float ex2(float x) { return __builtin_amdgcn_exp2f(x); }
__device__ __forceinline__ float gelu_tanh(float x) {
    const float z = x * (1.0f + 0.044715f * x * x) * (-2.0f * 0.7978845608028654f * 1.4426950408889634f);
    return x * __builtin_amdgcn_rcpf(1.0f + ex2(z));
}
__device__ __forceinline__ float sigmoidf_(float x) { return __builtin_amdgcn_rcpf(1.0f + ex2(-1.4426950408889634f * x)); }

__device__ __forceinline__ const void* ldptr(LAS unsigned char* lds, int i) {
    const LAS unsigned* p = (const LAS unsigned*)(lds + PTR_OFF) + 2 * i; const unsigned lo = __builtin_amdgcn_readfirstlane(p[0]), hi = __builtin_amdgcn_readfirstlane(p[1]);
    return (const void*)(const GAS void*)(((unsigned long long)hi << 32) | lo);
}
struct EpiInProj {
    static constexpr bool PERM = true, AFTER_DRAIN = false;
    const float* rstd; const float* cosT; const float* sinT; bf16* Q; bf16* Kk; bf16* XBR; bf16* GB;
    __device__ __forceinline__ void operator()(const pg8::f32x4 (&acc)[2][2][4][2], const pg8::Unit& u, int wr, int wc, int fr, int fq) const {
        const int row0 = u.pm * 256 + wr * 64 + fr; const int typ = u.pn >> 2, tt = u.pn & 3;
        if (typ < 2) {
            bf16* O = typ == 0 ? Q : Kk; const float sc = typ == 0 ? C2 : 1.0f;
            const int colb = tt * 256 + wc * 64 + 8 * fq;
#pragma unroll
            for (int ai = 0; ai < 2; ++ai)
#pragma unroll
                for (int m = 0; m < 4; ++m) {
                    const int row = row0 + ai * 128 + m * 16; const float rs = rstd[row] * sc;
                    const f32x4 c0 = *(const f32x4*)(cosT + (size_t)row * 32 + 8 * fq), c1 = *(const f32x4*)(cosT + (size_t)row * 32 + 8 * fq + 4);
                    const f32x4 s0 = *(const f32x4*)(sinT + (size_t)row * 32 + 8 * fq), s1 = *(const f32x4*)(sinT + (size_t)row * 32 + 8 * fq + 4);
                    const f32x4 a0 = acc[ai][0][m][0] * rs, a1 = acc[ai][0][m][1] * rs, b0 = acc[ai][1][m][0] * rs, b1 = acc[ai][1][m][1] * rs;
                    const f32x4 p0 = a0 * c0 - b0 * s0, p1 = a1 * c1 - b1 * s1, q0 = b0 * c0 + a0 * s0, q1 = b1 * c1 + a1 * s1;
                    v4u w1, w2;
                    w1.x = pg8::cvt_pk_bf16(p0[0], p0[1]); w1.y = pg8::cvt_pk_bf16(p0[2], p0[3]); w1.z = pg8::cvt_pk_bf16(p1[0], p1[1]); w1.w = pg8::cvt_pk_bf16(p1[2], p1[3]);
                    w2.x = pg8::cvt_pk_bf16(q0[0], q0[1]); w2.y = pg8::cvt_pk_bf16(q0[2], q0[3]); w2.z = pg8::cvt_pk_bf16(q1[0], q1[1]); w2.w = pg8::cvt_pk_bf16(q1[2], q1[3]);
                    bf16* rp = O + (size_t)row * 1024 + colb;
                    *(v4u*)rp = w1; *(v4u*)(rp + 32) = w2;
                }
        } else {
            bf16* O = typ == 2 ? XBR : GB; const int col0 = tt * 256 + wc * 32 + 8 * fq;
#pragma unroll
            for (int ai = 0; ai < 2; ++ai)
#pragma unroll
                for (int m = 0; m < 4; ++m) {
                    const int row = row0 + ai * 128 + m * 16; const float rs = rstd[row];
#pragma unroll
                    for (int bj = 0; bj < 2; ++bj) {
                        const f32x4 v0 = acc[ai][bj][m][0] * rs, v1 = acc[ai][bj][m][1] * rs; v4u w;
                        w.x = pg8::cvt_pk_bf16(v0[0], v0[1]); w.y = pg8::cvt_pk_bf16(v0[2], v0[3]); w.z = pg8::cvt_pk_bf16(v1[0], v1[1]); w.w = pg8::cvt_pk_bf16(v1[2], v1[3]);
                        *(v4u*)(O + (size_t)row * 1024 + col0 + bj * 128) = w;
                    }
                }
        }
    }
};
struct EpiVt {
    static constexpr bool PERM = true, AFTER_DRAIN = false;
    const float* rstd; bf16* Vt;
    __device__ __forceinline__ void operator()(const pg8::f32x4 (&acc)[2][2][4][2], const pg8::Unit& u, int wr, int wc, int fr, int fq) const {
        const int row0 = u.pm * 256 + wr * 64 + fr, col0 = u.pn * 256 + wc * 32 + 8 * fq;
        f32x4 rs[2][2];
#pragma unroll
        for (int bj = 0; bj < 2; ++bj) { rs[bj][0] = *(const f32x4*)(rstd + col0 + bj * 128); rs[bj][1] = *(const f32x4*)(rstd + col0 + bj * 128 + 4); }
#pragma unroll
        for (int ai = 0; ai < 2; ++ai)
#pragma unroll
            for (int m = 0; m < 4; ++m) {
                const int row = row0 + ai * 128 + m * 16;
#pragma unroll
                for (int bj = 0; bj < 2; ++bj) {
                    const f32x4 v0 = acc[ai][bj][m][0] * rs[bj][0], v1 = acc[ai][bj][m][1] * rs[bj][1]; v4u w;
                    w.x = pg8::cvt_pk_bf16(v0[0], v0[1]); w.y = pg8::cvt_pk_bf16(v0[2], v0[3]); w.z = pg8::cvt_pk_bf16(v1[0], v1[1]); w.w = pg8::cvt_pk_bf16(v1[2], v1[3]);
                    *(v4u*)(Vt + (size_t)row * M + col0 + bj * 128) = w;
                }
            }
    }
};
struct EpiResid {
    static constexpr bool PERM = false, AFTER_DRAIN = false;
    const float* xold; float* X; bf16* XB; float* SS; int row_off;
    __device__ __forceinline__ void operator()(const pg8::f32x4 (&acc)[2][2][4][2], const pg8::Unit& u, int wr, int wc, int fr, int fq) const {
        const int row0 = row_off + u.pm * 256 + wr * 64 + fr, col0 = u.pn * 256 + wc * 32 + 4 * fq;
#pragma unroll
        for (int ai = 0; ai < 2; ++ai)
#pragma unroll
            for (int m = 0; m < 4; ++m) {
                const int row = row0 + ai * 128 + m * 16; const size_t off = (size_t)row * DM + col0; float s = 0.f;
#pragma unroll
                for (int bj = 0; bj < 2; ++bj)
#pragma unroll
                    for (int n = 0; n < 2; ++n) {
                        const f32x4 xo = *(const f32x4*)(xold + off + bj * 128 + n * 16); const f32x4 v = xo + acc[ai][bj][m][n];
                        *(f32x4*)(X + off + bj * 128 + n * 16) = v;
                        u32x2 w; w.x = pg8::cvt_pk_bf16(v[0], v[1]); w.y = pg8::cvt_pk_bf16(v[2], v[3]);
                        *(u32x2*)(XB + off + bj * 128 + n * 16) = w;
                        s += (v[0] * v[0] + v[1] * v[1]) + (v[2] * v[2] + v[3] * v[3]);
                    }
                s += __shfl_xor(s, 16); s += __shfl_xor(s, 32);
                if (fq == 0) SS[(size_t)row * 32 + u.pn * 4 + wc] = s;
                asm volatile("" ::: "memory");
            }
    }
};
struct EpiUp {
    static constexpr bool PERM = true, AFTER_DRAIN = false;
    const float* rstd; bf16* U;
    __device__ __forceinline__ void operator()(const pg8::f32x4 (&acc)[2][2][4][2], const pg8::Unit& u, int wr, int wc, int fr, int fq) const {
        const int row0 = u.pm * 256 + wr * 64 + fr, col0 = u.pn * 256 + wc * 32 + 8 * fq;
#pragma unroll
        for (int ai = 0; ai < 2; ++ai)
#pragma unroll
            for (int m = 0; m < 4; ++m) {
                const int row = row0 + ai * 128 + m * 16; const float rs = rstd[row];
#pragma unroll
                for (int bj = 0; bj < 2; ++bj) {
                    const f32x4 v0 = acc[ai][bj][m][0] * rs, v1 = acc[ai][bj][m][1] * rs; v4u w;
                    w.x = pg8::cvt_pk_bf16(v0[0], v0[1]); w.y = pg8::cvt_pk_bf16(v0[2], v0[3]); w.z = pg8::cvt_pk_bf16(v1[0], v1[1]); w.w = pg8::cvt_pk_bf16(v1[2], v1[3]);
                    *(v4u*)(U + (size_t)row * DFF2 + col0 + bj * 128) = w;
                }
            }
    }
};

__device__ __forceinline__ void attn_unit(LAS unsigned char* lds, const bf16* Q, const bf16* Kk, const bf16* Vt, bf16* MIX, f32x4* stash, int b, int h, int qb, float lam) {
    int tid_ = threadIdx.x; asm volatile("" : "+v"(tid_));
    const int tid = tid_, lane = tid & 63, r32 = lane & 31, hi = lane >> 5; const int w = __builtin_amdgcn_readfirstlane(tid >> 6);
    LAS unsigned char* Kl = lds; LAS unsigned char* Vl = lds + 8192;
    const size_t rowbase = (size_t)b * SEQ; const int q0 = qb * 256, NT = (q0 + 256) / 64;
    const int qpos = q0 + 32 * w + r32, wqmin = q0 + 32 * w;
    const int krow = tid >> 3, kch = tid & 7; const int koff = krow * 128 + ((kch ^ ((krow >> 1) & 7)) << 4);
    const int vd0 = tid >> 3, vd1 = vd0 + 64; const int voff0 = vd0 * 128 + ((kch ^ ((vd0 >> 1) & 7)) << 4), voff1 = vd1 * 128 + ((kch ^ ((vd1 >> 1) & 7)) << 4);
    const bf16* vsrc0 = Vt + (size_t)(h * 128 + vd0) * M + rowbase + 8 * kch; const bf16* vsrc1 = vsrc0 + (size_t)64 * M;
    const int pi = (r32 & 0x13) | ((r32 & 4) << 1) | ((r32 & 8) >> 1); const int swk = (pi >> 1) & 7, swv = (r32 >> 1) & 7;
    const int kfb = pi * 128, vfb = r32 * 128;
    f32x4* st = stash + (size_t)w * 16 * 64 + lane;
#pragma unroll 1
    for (int c = 0; c < 2; ++c) {
        const bf16* Qp = Q + (rowbase + qpos) * 1024 + h * 128 + c * 64 + 8 * hi;
        bf16x8 qr[4];
#pragma unroll
        for (int ds = 0; ds < 4; ++ds) qr[ds] = *(const bf16x8*)(Qp + 16 * ds);
        const bf16* ksrc = Kk + (rowbase + krow) * 1024 + h * 128 + c * 64 + 8 * kch;
        f32x16 oT[4];
#pragma unroll
        for (int db = 0; db < 4; ++db)
#pragma unroll
            for (int i = 0; i < 16; ++i) oT[db][i] = 0.f;
        float mrun = -INFINITY, lsum = 0.f;
        v4u pk = *(const v4u*)ksrc, pv0 = *(const v4u*)vsrc0, pv1 = *(const v4u*)vsrc1;
#pragma unroll 1
        for (int kt = 0; kt < NT; ++kt) {
            __syncthreads();
            *(LAS v4u*)(Kl + koff) = pk; *(LAS v4u*)(Vl + voff0) = pv0; *(LAS v4u*)(Vl + voff1) = pv1;
            if (kt + 1 < NT) { pk = *(const v4u*)(ksrc + (size_t)(kt + 1) * 64 * 1024); pv0 = *(const v4u*)(vsrc0 + (kt + 1) * 64); pv1 = *(const v4u*)(vsrc1 + (kt + 1) * 64); }
            __syncthreads();
            if (64 * kt > wqmin + 31) continue;
            f32x16 p[2];
#pragma unroll
            for (int kb = 0; kb < 2; ++kb) {
#pragma unroll
                for (int i = 0; i < 16; ++i) p[kb][i] = 0.f;
#pragma unroll
                for (int ds = 0; ds < 4; ++ds) {
                    const bf16x8 kf = *(const LAS bf16x8*)(Kl + kb * 4096 + kfb + (((2 * ds + hi) ^ swk) << 4));
                    p[kb] = __builtin_amdgcn_mfma_f32_32x32x16_bf16(kf, qr[ds], p[kb], 0, 0, 0);
                }
            }
            if (64 * kt + 63 > wqmin) {
                const int kbase = 64 * kt + 8 * hi;
#pragma unroll
                for (int kb = 0; kb < 2; ++kb)
#pragma unroll
                    for (int i = 0; i < 16; ++i) { const int key = kbase + 32 * kb + 16 * (i >> 3) + (i & 7); if (key > qpos) p[kb][i] = -INFINITY; }
            }
            float mx = p[0][0];
#pragma unroll
            for (int i = 1; i < 16; ++i) mx = fmaxf(mx, p[0][i]);
#pragma unroll
            for (int i = 0; i < 16; ++i) mx = fmaxf(mx, p[1][i]);
            mx = fmaxf(mx, __shfl_xor(mx, 32));
            const float mnew = fmaxf(mrun, mx); const float alpha = ex2(mrun - mnew); mrun = mnew;
            float rs = 0.f;
#pragma unroll
            for (int kb = 0; kb < 2; ++kb)
#pragma unroll
                for (int i = 0; i < 16; ++i) { const float e = ex2(p[kb][i] - mnew); p[kb][i] = e; rs += e; }
            lsum = lsum * alpha + rs;
#pragma unroll
            for (int db = 0; db < 4; ++db)
#pragma unroll
                for (int i = 0; i < 16; ++i) oT[db][i] *= alpha;
            bf16x8 pf[4];
#pragma unroll
            for (int s = 0; s < 4; ++s) {
                const int kb = s >> 1, o = 8 * (s & 1); v4u t;
                t.x = pg8::cvt_pk_bf16(p[kb][o + 0], p[kb][o + 1]); t.y = pg8::cvt_pk_bf16(p[kb][o + 2], p[kb][o + 3]);
                t.z = pg8::cvt_pk_bf16(p[kb][o + 4], p[kb][o + 5]); t.w = pg8::cvt_pk_bf16(p[kb][o + 6], p[kb][o + 7]);
                pf[s] = __builtin_bit_cast(bf16x8, t);
            }
#pragma unroll
            for (int db = 0; db < 4; ++db)
#pragma unroll
                for (int s = 0; s < 4; ++s) {
                    const bf16x8 vf = *(const LAS bf16x8*)(Vl + db * 4096 + vfb + (((2 * s + hi) ^ swv) << 4));
                    oT[db] = __builtin_amdgcn_mfma_f32_32x32x16_bf16(vf, pf[s], oT[db], 0, 0, 0);
                }
        }
        const float lt = lsum + __shfl_xor(lsum, 32); const float inv = 1.0f / lt;
        if (c == 0) {
#pragma unroll
            for (int db = 0; db < 4; ++db)
#pragma unroll
                for (int g = 0; g < 4; ++g) { f32x4 v; v[0] = oT[db][4 * g] * inv; v[1] = oT[db][4 * g + 1] * inv; v[2] = oT[db][4 * g + 2] * inv; v[3] = oT[db][4 * g + 3] * inv; st[(db * 4 + g) * 64] = v; }
        } else {
            const float li = lam * inv; float ss = 0.f;
#pragma unroll
            for (int db = 0; db < 4; ++db)
#pragma unroll
                for (int g = 0; g < 4; ++g) { const f32x4 o0 = st[(db * 4 + g) * 64];
#pragma unroll
                    for (int e = 0; e < 4; ++e) { const float o = o0[e] - li * oT[db][4 * g + e]; oT[db][4 * g + e] = o; ss += o * o; } }
            ss += __shfl_xor(ss, 32);
            const float rn = 1.0f / sqrtf(ss * (1.0f / 128.0f) + EPS);
            bf16* op = MIX + (rowbase + qpos) * DM + h * 128 + 4 * hi;
#pragma unroll
            for (int db = 0; db < 4; ++db)
#pragma unroll
                for (int g = 0; g < 4; ++g) { u32x2 wv; wv.x = pg8::cvt_pk_bf16(oT[db][4 * g] * rn, oT[db][4 * g + 1] * rn); wv.y = pg8::cvt_pk_bf16(oT[db][4 * g + 2] * rn, oT[db][4 * g + 3] * rn);
                    *(u32x2*)(op + 32 * db + 8 * g) = wv; }
        }
    }
}

constexpr int L_XCB = 0, XCB_STRIDE = 272, L_AF = 17408, L_BF = L_AF + 32768, L_SUB = L_BF + 32768;
__device__ __forceinline__ void lru_local_unit(LAS unsigned char* lds, const bf16* XBR, const float* cw, const float* cbias, const bf16* WG, const float* gab, const float* gxb, const float* lam_p,
                                               float* HLOC, float* CUMA, float* CHP, float* CHH, int b, int ck, int hb) {
    int tid_ = threadIdx.x; asm volatile("" : "+v"(tid_));
    const int tid = tid_, lane = tid & 63; const int w = __builtin_amdgcn_readfirstlane(tid >> 6);
    LAS float* AF = (LAS float*)(lds + L_AF); LAS float* BF = (LAS float*)(lds + L_BF); LAS float* SUBP = (LAS float*)(lds + L_SUB); LAS float* SUBH = SUBP + 512;
    const size_t rowbase = (size_t)b * SEQ; const int t0 = ck * LCH;
    __syncthreads();
#pragma unroll
    for (int it = 0; it < 2; ++it) {
        const int item = tid + 512 * it; const int tl = item >> 4, cg = item & 15; const int t = t0 + tl; const int ch = hb * 128 + cg * 8;
        float xc[8];
        { const f32x4 b0 = *(const f32x4*)(cbias + ch), b1 = *(const f32x4*)(cbias + ch + 4); xc[0] = b0[0]; xc[1] = b0[1]; xc[2] = b0[2]; xc[3] = b0[3]; xc[4] = b1[0]; xc[5] = b1[1]; xc[6] = b1[2]; xc[7] = b1[3]; }
#pragma unroll
        for (int j = 0; j < 4; ++j) {
            const int ts = t - 3 + j;
            if (ts >= 0) {
                const v4u xv = *(const v4u*)(XBR + (rowbase + ts) * 1024 + ch);
                const f32x4 w0 = *(const f32x4*)(cw + j * LW + ch), w1 = *(const f32x4*)(cw + j * LW + ch + 4);
                xc[0] += w0[0] * bflo(xv.x); xc[1] += w0[1] * bfhi(xv.x); xc[2] += w0[2] * bflo(xv.y); xc[3] += w0[3] * bfhi(xv.y);
                xc[4] += w1[0] * bflo(xv.z); xc[5] += w1[1] * bfhi(xv.z); xc[6] += w1[2] * bflo(xv.w); xc[7] += w1[3] * bfhi(xv.w);
            }
        }
        v4u pw; pw.x = pg8::cvt_pk_bf16(xc[0], xc[1]); pw.y = pg8::cvt_pk_bf16(xc[2], xc[3]); pw.z = pg8::cvt_pk_bf16(xc[4], xc[5]); pw.w = pg8::cvt_pk_bf16(xc[6], xc[7]);
        *(LAS v4u*)(lds + L_XCB + tl * XCB_STRIDE + cg * 16) = pw;
        f32x4 f0, f1; f0[0] = xc[0]; f0[1] = xc[1]; f0[2] = xc[2]; f0[3] = xc[3]; f1[0] = xc[4]; f1[1] = xc[5]; f1[2] = xc[6]; f1[3] = xc[7];
        *(LAS f32x4*)(BF + tl * 128 + cg * 8) = f0; *(LAS f32x4*)(BF + tl * 128 + cg * 8 + 4) = f1;
    }
    __syncthreads();
    {
        const int n = lane & 15, quad = lane >> 4; const int chl = 16 * w + n, chg = hb * 128 + chl;
        bf16x8 bw[2][4];
#pragma unroll
        for (int g = 0; g < 2; ++g)
#pragma unroll
            for (int ks = 0; ks < 4; ++ks) bw[g][ks] = *(const bf16x8*)(WG + ((size_t)(hb * 2 + g) * 128 + chl) * 128 + 32 * ks + 8 * quad);
        const float ba = gab[chg], bx = gxb[chg];
        const float lp = lam_p[chg]; const float sp8 = -8.0f * log1pf(expf(-lp));
#pragma unroll
        for (int mt = 0; mt < 4; ++mt) {
            f32x4 ga = {0.f, 0.f, 0.f, 0.f}, gx = {0.f, 0.f, 0.f, 0.f};
#pragma unroll
            for (int ks = 0; ks < 4; ++ks) {
                const bf16x8 af = *(const LAS bf16x8*)(lds + L_XCB + (16 * mt + n) * XCB_STRIDE + (32 * ks + 8 * quad) * 2);
                ga = __builtin_amdgcn_mfma_f32_16x16x32_bf16(af, bw[0][ks], ga, 0, 0, 0);
                gx = __builtin_amdgcn_mfma_f32_16x16x32_bf16(af, bw[1][ks], gx, 0, 0, 0);
            }
#pragma unroll
            for (int jj = 0; jj < 4; ++jj) {
                const int tl = 16 * mt + 4 * quad + jj;
                const float r = sigmoidf_(ga[jj] + ba), ig = sigmoidf_(gx[jj] + bx);
                const float la = sp8 * r; const float a = expf(la); const float mult = sqrtf(-expm1f(2.0f * la));
                const float xcv = BF[tl * 128 + chl];
                AF[tl * 128 + chl] = a; BF[tl * 128 + chl] = mult * ig * xcv;
            }
        }
    }
    __syncthreads();
    const int ch = tid & 127, sub = tid >> 7;
    {
        float hh = 0.f, P = 1.f;
#pragma unroll
        for (int tt = 0; tt < 16; ++tt) { const int idx = (16 * sub + tt) * 128 + ch; const float a = AF[idx], bb = BF[idx]; hh = a * hh + bb; P *= a; BF[idx] = hh; AF[idx] = P; }
        SUBP[sub * 128 + ch] = P; SUBH[sub * 128 + ch] = hh;
    }
    __syncthreads();
    {
        float carry = 0.f, Pp = 1.f;
#pragma unroll
        for (int s = 0; s < 3; ++s) if (s < sub) { const float ps = SUBP[s * 128 + ch]; carry = ps * carry + SUBH[s * 128 + ch]; Pp *= ps; }
        const size_t gbase = (rowbase + t0 + 16 * sub) * 1024 + hb * 128 + ch;
#pragma unroll
        for (int tt = 0; tt < 16; ++tt) { const int idx = (16 * sub + tt) * 128 + ch; const float pl = AF[idx]; HLOC[gbase + (size_t)tt * 1024] = BF[idx] + pl * carry; CUMA[gbase + (size_t)tt * 1024] = pl * Pp; }
        if (sub == 3) { const float p3 = SUBP[3 * 128 + ch]; const size_t so = ((size_t)b * NCH + ck) * 1024 + hb * 128 + ch; CHP[so] = Pp * p3; CHH[so] = p3 * carry + SUBH[3 * 128 + ch]; }
    }
}

__device__ __forceinline__ void lru_fix_unit(LAS unsigned char* lds, const float* HLOC, const float* CUMA, const float* CHP, const float* CHH, const bf16* GB, bf16* MIX, int b, int ck) {
    int tid_ = threadIdx.x; asm volatile("" : "+v"(tid_));
    const int tid = tid_, lane = tid & 63; const int w = __builtin_amdgcn_readfirstlane(tid >> 6);
    LAS float* CARRY = (LAS float*)lds;
    __syncthreads();
    {
        float c0 = 0.f, c1 = 0.f; const size_t so = (size_t)b * NCH * 1024 + 2 * tid;
#pragma unroll 4
        for (int k = 0; k < ck; ++k) { const f32x2v_t pp = *(const f32x2v_t*)(CHP + so + (size_t)k * 1024), hh = *(const f32x2v_t*)(CHH + so + (size_t)k * 1024); c0 = pp.x * c0 + hh.x; c1 = pp.y * c1 + hh.y; }
        CARRY[2 * tid] = c0; CARRY[2 * tid + 1] = c1;
    }
    __syncthreads();
    float cr[16];
#pragma unroll
    for (int g = 0; g < 2; ++g) { const int cb = g * 512 + lane * 8; const f32x4 a = *(const LAS f32x4*)(CARRY + cb), bq = *(const LAS f32x4*)(CARRY + cb + 4);
        cr[g * 8 + 0] = a[0]; cr[g * 8 + 1] = a[1]; cr[g * 8 + 2] = a[2]; cr[g * 8 + 3] = a[3]; cr[g * 8 + 4] = bq[0]; cr[g * 8 + 5] = bq[1]; cr[g * 8 + 6] = bq[2]; cr[g * 8 + 7] = bq[3]; }
#pragma unroll 1
    for (int k = 0; k < 8; ++k) {
        const size_t row = (size_t)b * SEQ + ck * LCH + w + 8 * k; float y[16]; float ss = 0.f;
#pragma unroll
        for (int g = 0; g < 2; ++g) {
            const int cb = g * 512 + lane * 8;
            const f32x4 h0 = *(const f32x4*)(HLOC + row * 1024 + cb), h1 = *(const f32x4*)(HLOC + row * 1024 + cb + 4);
            const f32x4 p0 = *(const f32x4*)(CUMA + row * 1024 + cb), p1 = *(const f32x4*)(CUMA + row * 1024 + cb + 4);
            const v4u gv = *(const v4u*)(GB + row * 1024 + cb);
            const float gg[8] = {bflo(gv.x), bfhi(gv.x), bflo(gv.y), bfhi(gv.y), bflo(gv.z), bfhi(gv.z), bflo(gv.w), bfhi(gv.w)};
#pragma unroll
            for (int e = 0; e < 4; ++e) { const float hv = h0[e] + p0[e] * cr[g * 8 + e]; const float yv = hv * gelu_tanh(gg[e]); y[g * 8 + e] = yv; ss += yv * yv; }
#pragma unroll
            for (int e = 0; e < 4; ++e) { const float hv = h1[e] + p1[e] * cr[g * 8 + 4 + e]; const float yv = hv * gelu_tanh(gg[4 + e]); y[g * 8 + 4 + e] = yv; ss += yv * yv; }
        }
        ss = wave_sum(ss); const float rn = 1.0f / sqrtf(ss * (1.0f / 1024.0f) + EPS);
#pragma unroll
        for (int g = 0; g < 2; ++g) { v4u o; o.x = pg8::cvt_pk_bf16(y[g * 8] * rn, y[g * 8 + 1] * rn); o.y = pg8::cvt_pk_bf16(y[g * 8 + 2] * rn, y[g * 8 + 3] * rn);
            o.z = pg8::cvt_pk_bf16(y[g * 8 + 4] * rn, y[g * 8 + 5] * rn); o.w = pg8::cvt_pk_bf16(y[g * 8 + 6] * rn, y[g * 8 + 7] * rn);
            *(v4u*)(MIX + row * DM + 1024 + g * 512 + lane * 8) = o; }
    }
}

__device__ __forceinline__ void ffn_conv_phase(const bf16* U, bf16* ACT, const float* cw, const float* cb, int vcu, int G, int tid) {
    const int nth = G * 512;
#pragma unroll 1
    for (int id = vcu * 512 + tid; id < (MH / 16) * (DFF / 8); id += nth) {
        const int tc = id / (DFF / 8), cg = id - tc * (DFF / 8); const int r0 = tc * 16, c = cg * 8;
        float wg[3][8], wv[3][8], bg[8], bv[8];
#pragma unroll
        for (int j = 0; j < 3; ++j) {
            const f32x4 a0 = *(const f32x4*)(cw + j * DFF2 + c), a1 = *(const f32x4*)(cw + j * DFF2 + c + 4), v0 = *(const f32x4*)(cw + j * DFF2 + DFF + c), v1 = *(const f32x4*)(cw + j * DFF2 + DFF + c + 4);
#pragma unroll
            for (int e = 0; e < 4; ++e) { wg[j][e] = a0[e]; wg[j][4 + e] = a1[e]; wv[j][e] = v0[e]; wv[j][4 + e] = v1[e]; }
        }
        { const f32x4 a0 = *(const f32x4*)(cb + c), a1 = *(const f32x4*)(cb + c + 4), v0 = *(const f32x4*)(cb + DFF + c), v1 = *(const f32x4*)(cb + DFF + c + 4);
#pragma unroll
          for (int e = 0; e < 4; ++e) { bg[e] = a0[e]; bg[4 + e] = a1[e]; bv[e] = v0[e]; bv[4 + e] = v1[e]; } }
        float g2[8], g1[8], v2[8], v1_[8];
        const bool seq_start = ((r0 & (SEQ - 1)) == 0);
        if (seq_start) {
#pragma unroll
            for (int e = 0; e < 8; ++e) { g2[e] = 0.f; g1[e] = 0.f; v2[e] = 0.f; v1_[e] = 0.f; }
        } else {
            const v4u a = *(const v4u*)(U + (size_t)(r0 - 2) * DFF2 + c), bq = *(const v4u*)(U + (size_t)(r0 - 1) * DFF2 + c);
            const v4u cq = *(const v4u*)(U + (size_t)(r0 - 2) * DFF2 + DFF + c), dq = *(const v4u*)(U + (size_t)(r0 - 1) * DFF2 + DFF + c);
            g2[0] = bflo(a.x); g2[1] = bfhi(a.x); g2[2] = bflo(a.y); g2[3] = bfhi(a.y); g2[4] = bflo(a.z); g2[5] = bfhi(a.z); g2[6] = bflo(a.w); g2[7] = bfhi(a.w);
            g1[0] = bflo(bq.x); g1[1] = bfhi(bq.x); g1[2] = bflo(bq.y); g1[3] = bfhi(bq.y); g1[4] = bflo(bq.z); g1[5] = bfhi(bq.z); g1[6] = bflo(bq.w); g1[7] = bfhi(bq.w);
            v2[0] = bflo(cq.x); v2[1] = bfhi(cq.x); v2[2] = bflo(cq.y); v2[3] = bfhi(cq.y); v2[4] = bflo(cq.z); v2[5] = bfhi(cq.z); v2[6] = bflo(cq.w); v2[7] = bfhi(cq.w);
            v1_[0] = bflo(dq.x); v1_[1] = bfhi(dq.x); v1_[2] = bflo(dq.y); v1_[3] = bfhi(dq.y); v1_[4] = bflo(dq.z); v1_[5] = bfhi(dq.z); v1_[6] = bflo(dq.w); v1_[7] = bfhi(dq.w);
        }
#pragma unroll
        for (int tt = 0; tt < 16; ++tt) {
            const v4u a = *(const v4u*)(U + (size_t)(r0 + tt) * DFF2 + c), cq = *(const v4u*)(U + (size_t)(r0 + tt) * DFF2 + DFF + c);
            float g0[8], v0[8];
            g0[0] = bflo(a.x); g0[1] = bfhi(a.x); g0[2] = bflo(a.y); g0[3] = bfhi(a.y); g0[4] = bflo(a.z); g0[5] = bfhi(a.z); g0[6] = bflo(a.w); g0[7] = bfhi(a.w);
            v0[0] = bflo(cq.x); v0[1] = bfhi(cq.x); v0[2] = bflo(cq.y); v0[3] = bfhi(cq.y); v0[4] = bflo(cq.z); v0[5] = bfhi(cq.z); v0[6] = bflo(cq.w); v0[7] = bfhi(cq.w);
            float o[8];
#pragma unroll
            for (int e = 0; e < 8; ++e) {
                const float ug = bg[e] + wg[0][e] * g2[e] + wg[1][e] * g1[e] + wg[2][e] * g0[e];
                const float uv = bv[e] + wv[0][e] * v2[e] + wv[1][e] * v1_[e] + wv[2][e] * v0[e];
                o[e] = gelu_tanh(ug) * uv; g2[e] = g1[e]; g1[e] = g0[e]; v2[e] = v1_[e]; v1_[e] = v0[e];
            }
            v4u ow; ow.x = pg8::cvt_pk_bf16(o[0], o[1]); ow.y = pg8::cvt_pk_bf16(o[2], o[3]); ow.z = pg8::cvt_pk_bf16(o[4], o[5]); ow.w = pg8::cvt_pk_bf16(o[6], o[7]);
            *(v4u*)(ACT + (size_t)(r0 + tt) * DFF + c) = ow;
        }
    }
}

struct GainNone { __device__ __forceinline__ float operator()(int) const { return 1.0f; } };
struct GainVec { const float* g; __device__ __forceinline__ float operator()(int k) const { return g[k]; } };
struct GainOut { const float* subln; const float* lnorm; float s; __device__ __forceinline__ float operator()(int k) const { return k < 1024 ? subln[k & 127] * s : lnorm[k - 1024]; } };
template <class GF>
__device__ __forceinline__ void tr_item(const float* W, int N, int K, bf16* WT, int dst_row0, int k0, int n0, const GF& gain, LAS float* scr, int lane) {
#pragma unroll 8
    for (int i = 0; i < 32; ++i) { const int kk = 2 * i + (lane >> 5); scr[kk * 33 + (lane & 31)] = W[(size_t)(k0 + kk) * N + n0 + (lane & 31)] * gain(k0 + kk); }
    LDS_WAIT(); asm volatile("" ::: "memory");
    const int c = lane & 7;
#pragma unroll
    for (int j = 0; j < 4; ++j) { const int n = (lane >> 3) + 8 * j; const LAS float* s = scr + (8 * c) * 33 + n;
        v4u o; o.x = pk2(s[0 * 33], s[1 * 33]); o.y = pk2(s[2 * 33], s[3 * 33]); o.z = pk2(s[4 * 33], s[5 * 33]); o.w = pk2(s[6 * 33], s[7 * 33]);
        *(GAS v4u*)(WT + (size_t)(dst_row0 + n) * K + k0 + 8 * c) = o; }
    LDS_WAIT(); asm volatile("" ::: "memory");
}
__device__ __forceinline__ int map_in(int n0) {
    const int sec = n0 >> 10, lc = n0 & 1023;
    if (sec < 2) { const int tt = lc >> 8, lb = (lc >> 5) & 7; return sec * 1024 + tt * 256 + (lb & 1) * 128 + (lb >> 1) * 32; }
    if (sec == 2) return 4096 + lc;
    return (sec - 1) * 1024 + lc;
}

struct Args { const void* in[24]; float* out; unsigned char* ws; };

__global__ void __launch_bounds__(NWAVES * 64, 2) mega_fwd(Args args) {
    extern __shared__ __attribute__((aligned(16))) unsigned char lds_raw[];
    LAS unsigned char* lds = (LAS unsigned char*)lds_raw;
    volatile LAS unsigned* MISC = (volatile LAS unsigned*)(lds + MISC_OFF);
    const int tid = threadIdx.x, lane = tid & 63; const int wave = __builtin_amdgcn_readfirstlane(tid >> 6);
    const int G = gridDim.x; int vcu; { const int bx = blockIdx.x; vcu = (G % 8 == 0) ? (bx % 8) * (G / 8) + bx / 8 : bx; }
    unsigned char* ws = args.ws;
    gu32* ctl = (gu32*)(ws + WS_CTL);
#define INP(T, i) ((const T*)ldptr(lds, (i)))
#define x_in INP(float, 0)
#define positions INP(int, 1)
#define attn_norm INP(float, 2)
#define w_in INP(float, 3)
#define lq1 INP(float, 4)
#define lk1 INP(float, 5)
#define lq2 INP(float, 6)
#define lk2 INP(float, 7)
#define subln INP(float, 8)
#define lru_conv_w INP(float, 9)
#define lru_conv_b INP(float, 10)
#define gate_a_w INP(float, 11)
#define gate_a_b INP(float, 12)
#define gate_x_w INP(float, 13)
#define gate_x_b INP(float, 14)
#define lru_lambda INP(float, 15)
#define lru_norm INP(float, 16)
#define w_out INP(float, 17)
#define mlp_norm INP(float, 18)
#define w_up INP(float, 19)
#define ffn_conv_w INP(float, 20)
#define ffn_conv_b INP(float, 21)
#define w_down INP(float, 22)
#define final_norm INP(float, 23)
#define X ((float*)ldptr(lds, 24))
#define WSB ((unsigned char*)ldptr(lds, 25))
#define WG ((bf16*)(WSB + WS_WG))
#define COS ((float*)(WSB + WS_COS))
#define SIN ((float*)(WSB + WS_SIN))
#define RSTD ((float*)(WSB + WS_RSTD))
#define SS ((float*)(WSB + WS_SS))
#define CHP ((float*)(WSB + WS_CHP))
#define CHH ((float*)(WSB + WS_CHH))
#define WIN ((bf16*)(WSB + WS_WIN))
#define WOUT ((bf16*)(WSB + WS_WOUT))
#define WUP ((bf16*)(WSB + WS_WUP))
#define WDN ((bf16*)(WSB + WS_WDN))
#define XB ((bf16*)(WSB + WS_XB))
#define Qb ((bf16*)(WSB + WS_Q))
#define Kb ((bf16*)(WSB + WS_K))
#define VT ((bf16*)(WSB + WS_VT))
#define XBR ((bf16*)(WSB + WS_XBR))
#define GBb ((bf16*)(WSB + WS_GB))
#define MIX ((bf16*)(WSB + WS_MIX))
#define HLOC ((float*)(WSB + WS_HLOC))
#define CUMA ((float*)(WSB + WS_CUMA))
#define STASH ((f32x4*)(WSB + WS_STASH))
#define Ub ((bf16*)(WSB + WS_U))
#define ACT ((bf16*)(WSB + WS_ACT))
    for (int u = tid; u < (LDS_BYTES - LDSCTL_OFF) / 4; u += NWAVES * 64) ((LAS unsigned*)(lds + LDSCTL_OFF))[u] = 0u;
    __syncthreads();
    { LAS unsigned long long* PT = (LAS unsigned long long*)(lds + PTR_OFF); if (tid < 24) PT[tid] = (unsigned long long)args.in[tid]; if (tid == 24) PT[24] = (unsigned long long)args.out; if (tid == 25) PT[25] = (unsigned long long)args.ws; }
    __syncthreads();
    XcdBarrier bar = xcd_barrier_post((unsigned*)(ctl + CW_BAR), MISC + 8);
#define GRID_BAR() xcd_barrier(bar)

#pragma unroll 1
    for (int rep = 0; rep < REP_PRO; ++rep) {
        LAS float* scr = (LAS float*)(lds + RING_OFF + wave * 16384);
        const int gw = vcu * NWAVES + wave, NGW = G * NWAVES;
        constexpr int I_IN = 32 * 160, I_OUT = 32 * 64, I_UP = 32 * 384, I_DN = 96 * 64, I_G = 128, I_L = I_IN + I_OUT + I_UP + I_DN + I_G;
#pragma unroll 1
        for (int it = gw; it < DEPTH * I_L; it += NGW) {
            const int l = it / I_L; int r = it - l * I_L;
            if (r < I_IN) { const int kb = r / 160, nb = r - kb * 160; tr_item(w_in + (size_t)l * DM * INW, INW, DM, WIN + (size_t)l * INW * DM, map_in(32 * nb), 64 * kb, 32 * nb, GainVec{attn_norm + l * DM}, scr, lane); continue; } r -= I_IN;
            if (r < I_OUT) { const int kb = r / 64, nb = r - kb * 64; const float li = 0.8f - 0.6f * expf(-0.3f * (float)l);
                tr_item(w_out + (size_t)l * DM * DM, DM, DM, WOUT + (size_t)l * DM * DM, 32 * nb, 64 * kb, 32 * nb, GainOut{subln + l * VD, lru_norm + l * LW, 1.0f - li}, scr, lane); continue; } r -= I_OUT;
            if (r < I_UP) { const int kb = r / 384, nb = r - kb * 384; tr_item(w_up + (size_t)l * DM * DFF2, DFF2, DM, WUP + (size_t)l * DFF2 * DM, 32 * nb, 64 * kb, 32 * nb, GainVec{mlp_norm + l * DM}, scr, lane); continue; } r -= I_UP;
            if (r < I_DN) { const int kb = r / 64, nb = r - kb * 64; tr_item(w_down + (size_t)l * DFF * DM, DM, DFF, WDN + (size_t)l * DM * DFF, 32 * nb, 64 * kb, 32 * nb, GainNone{}, scr, lane); continue; } r -= I_DN;
            { const int mat = r >> 3, sub = r & 7; const int hb = mat >> 1, g = mat & 1; const int kb = sub >> 2, nb = sub & 3;
              const float* src = (g == 0 ? gate_a_w : gate_x_w) + ((size_t)l * NLB + hb) * LBLK * LBLK;
              tr_item(src, LBLK, LBLK, WG + (((size_t)l * NLB + hb) * 2 + g) * LBLK * LBLK, 32 * nb, 64 * kb, 32 * nb, GainNone{}, scr, lane); }
        }
#pragma unroll 1
        for (int id = vcu * 512 + tid; id < M * 32; id += G * 512) {
            const int row = id >> 5, i = id & 31;
            const float inv = 1.0f / powf(10000.0f, (float)(2 * i) * (1.0f / 64.0f));
            const float ang = (float)positions[row] * inv; float sv, cv; sincosf(ang, &sv, &cv);
            COS[id] = cv; SIN[id] = sv;
        }
#pragma unroll 1
        for (int row = gw; row < M; row += NGW) {
            const GAS f32x4* xr = (const GAS f32x4*)(x_in + (size_t)row * DM) + lane; float s = 0.f; f32x4 v[8];
#pragma unroll
            for (int j = 0; j < 8; ++j) { v[j] = xr[64 * j]; s += (v[j][0] * v[j][0] + v[j][1] * v[j][1]) + (v[j][2] * v[j][2] + v[j][3] * v[j][3]); }
            s = wave_sum(s);
            if (lane == 0) RSTD[row] = 1.0f / sqrtf(s * (1.0f / DM) + EPS);
            GAS u32x2* o8 = (GAS u32x2*)(XB + (size_t)row * DM) + lane;
#pragma unroll
            for (int j = 0; j < 8; ++j) { u32x2 o; o.x = pk2(v[j][0], v[j][1]); o.y = pk2(v[j][2], v[j][3]); o8[64 * j] = o; }
        }
    }
    GRID_BAR();

#pragma unroll 1
    for (int l = 0; l < DEPTH; ++l) {
        const float lam_init = 0.8f - 0.6f * expf(-0.3f * (float)l);
#pragma unroll 1
        for (int rep = 0; rep < REP_P1; ++rep) {
        {
            pg8::Gemm g{XB, WIN + (size_t)l * INW * DM, M, 4096, DM}; pg8::StaticOrder S; S.init(M, 4096, G, (int)blockIdx.x);
            EpiInProj E{RSTD, COS, SIN, Qb, Kb, XBR, GBb};
            pg8::gemm_phase<EpiInProj, pg8::StaticOrder, true, true>(lds + RING_OFF, g, S, E);
        }
        {
            pg8::Gemm g{WIN + (size_t)l * INW * DM + (size_t)4096 * DM, XB, 1024, M, DM}; pg8::StaticOrder S; S.init(1024, M, G, (int)blockIdx.x);
            EpiVt E{RSTD, VT};
            pg8::gemm_phase<EpiVt, pg8::StaticOrder, true, true>(lds + RING_OFF, g, S, E);
        }
        }
        GRID_BAR();
        {
            float lam;
            { const float a = lq1[l * QKD + lane] * lk1[l * QKD + lane], bq = lq2[l * QKD + lane] * lk2[l * QKD + lane];
              lam = expf(wave_sum(a)) - expf(wave_sum(bq)) + lam_init; }
#pragma unroll 1
            for (int i4 = 0; i4 < 4 * REP_ATTN; ++i4) { const int i = i4 & 3;
                const int pidx = vcu + G * (i >> 1);
                if (pidx < BATCH * NHEAD * 8) {
                    const int bh = pidx >> 3, s = pidx & 7; const int qb = (i & 1) ? 15 - s : s;
                    attn_unit(lds, Qb, Kb, VT, MIX, STASH + ((size_t)blockIdx.x * 4 + i) * (8 * 16 * 64), bh >> 3, bh & 7, qb, lam);
                }
            }
#pragma unroll 1
            for (int uu = vcu; uu < BATCH * NCH * NLB * REP_LRUL; uu += G) { const int uidx = uu & (BATCH * NCH * NLB - 1);
                const int hb = uidx & 7, ck = (uidx >> 3) & (NCH - 1), b = uidx >> 9;
                lru_local_unit(lds, XBR, lru_conv_w + (size_t)l * 4 * LW, lru_conv_b + (size_t)l * LW, WG + (size_t)l * NLB * 2 * LBLK * LBLK, gate_a_b + (size_t)l * LW, gate_x_b + (size_t)l * LW,
                               lru_lambda + (size_t)l * LW, HLOC, CUMA, CHP, CHH, b, ck, hb);
            }
        }
        GRID_BAR();
#pragma unroll 1
        for (int uu = vcu; uu < BATCH * NCH * REP_LRUF; uu += G) { const int uidx = uu & (BATCH * NCH - 1); lru_fix_unit(lds, HLOC, CUMA, CHP, CHH, GBb, MIX, uidx >> 6, uidx & (NCH - 1)); }
        GRID_BAR();
#pragma unroll 1
        for (int rep = 0; rep < REP_P4; ++rep) {
            pg8::Gemm g{MIX, WOUT + (size_t)l * DM * DM, M, DM, DM}; pg8::StaticOrder S; S.init(M, DM, G, (int)blockIdx.x);
            EpiResid E{l == 0 ? x_in : X, rep == 0 ? X : (float*)(WSB + WS_HLOC), rep == 0 ? XB : (bf16*)(WSB + WS_STASH), rep == 0 ? SS : (float*)(WSB + WS_CHP), 0};
            pg8::gemm_phase<EpiResid, pg8::StaticOrder, true, true>(lds + RING_OFF, g, S, E);
        }
        GRID_BAR();
#pragma unroll 1
        for (int id = vcu * 512 + tid; id < M * 4; id += G * 512) {
            const int row = id >> 2, part = id & 3; const f32x4 a = *(const f32x4*)(SS + (size_t)row * 32 + part * 8), bq = *(const f32x4*)(SS + (size_t)row * 32 + part * 8 + 4);
            float s = (a[0] + a[1]) + (a[2] + a[3]) + (bq[0] + bq[1]) + (bq[2] + bq[3]); s += __shfl_xor(s, 1); s += __shfl_xor(s, 2);
            if (part == 0) RSTD[row] = 1.0f / sqrtf(s * (1.0f / DM) + EPS);
        }
        GRID_BAR();
#pragma unroll 1
        for (int hf = 0; hf < 2; ++hf) {
#pragma unroll 1
            for (int rep = 0; rep < REP_UP; ++rep) {
                pg8::Gemm g{XB + (size_t)hf * MH * DM, WUP + (size_t)l * DFF2 * DM, MH, DFF2, DM}; pg8::StaticOrder S; S.init(MH, DFF2, G, (int)blockIdx.x);
                EpiUp E{RSTD + hf * MH, Ub};
                pg8::gemm_phase<EpiUp, pg8::StaticOrder, true, true>(lds + RING_OFF, g, S, E);
            }
            GRID_BAR();
#pragma unroll 1
            for (int rep = 0; rep < REP_FFNC; ++rep)
            ffn_conv_phase(Ub, ACT + (size_t)hf * MH * DFF, ffn_conv_w + (size_t)l * 3 * DFF2, ffn_conv_b + (size_t)l * DFF2, vcu, G, tid);
            GRID_BAR();
        }
#pragma unroll 1
        for (int rep = 0; rep < REP_P7; ++rep) {
            pg8::Gemm g{ACT, WDN + (size_t)l * DM * DFF, M, DM, DFF}; pg8::StaticOrder S; S.init(M, DM, G, (int)blockIdx.x);
            EpiResid E{X, rep == 0 ? X : (float*)(WSB + WS_Q), rep == 0 ? XB : (bf16*)(WSB + WS_Q + 256 * MiB), rep == 0 ? SS : (float*)(WSB + WS_CHP), 0};
            pg8::gemm_phase<EpiResid, pg8::StaticOrder, true, true>(lds + RING_OFF, g, S, E);
        }
        GRID_BAR();
        if (l + 1 < DEPTH) {
#pragma unroll 1
            for (int id = vcu * 512 + tid; id < M * 4; id += G * 512) {
                const int row = id >> 2, part = id & 3; const f32x4 a = *(const f32x4*)(SS + (size_t)row * 32 + part * 8), bq = *(const f32x4*)(SS + (size_t)row * 32 + part * 8 + 4);
                float s = (a[0] + a[1]) + (a[2] + a[3]) + (bq[0] + bq[1]) + (bq[2] + bq[3]); s += __shfl_xor(s, 1); s += __shfl_xor(s, 2);
                if (part == 0) RSTD[row] = 1.0f / sqrtf(s * (1.0f / DM) + EPS);
            }
            GRID_BAR();
        }
    }
    {
        const int gw = vcu * NWAVES + wave, NGW = G * NWAVES;
        const unsigned bad = __hip_atomic_load((gu32*)(ctl + CW_BAR + XB_TMO), RLX_AGENT);
#pragma unroll 1
        for (int row = gw; row < M; row += NGW) {
            GAS f32x4* xr = (GAS f32x4*)(X + (size_t)row * DM) + lane; float s = 0.f; f32x4 v[8];
#pragma unroll
            for (int j = 0; j < 8; ++j) { v[j] = xr[64 * j]; s += (v[j][0] * v[j][0] + v[j][1] * v[j][1]) + (v[j][2] * v[j][2] + v[j][3] * v[j][3]); }
            s = wave_sum(s); float rn = 1.0f / sqrtf(s * (1.0f / DM) + EPS); if (bad) rn = __builtin_nanf("");
#pragma unroll
            for (int j = 0; j < 8; ++j) { const f32x4 gg = *(const f32x4*)(final_norm + 256 * j + 4 * lane); xr[64 * j] = v[j] * rn * gg; }
        }
    }
}

extern "C" void kernel_launch(void* const* d_in, const int* in_sizes, int n_in, void* d_out, int out_size, void* d_ws, size_t ws_size, hipStream_t stream) {
    static int grid = 0;
    if (grid == 0) {
        if (n_in != 24 || in_sizes[0] != M * DM || out_size != M * DM || ws_size < WS_END) {
            fprintf(stderr, "kernel_launch: shape/workspace mismatch: n_in %d in0 %d out %d ws %zu (need %zu)\n", n_in, n_in > 0 ? in_sizes[0] : -1, out_size, ws_size, (size_t)WS_END); grid = -1; return; }
        int dev = 0, cus = 0, per_cu = 0;
        if (hipGetDevice(&dev) != hipSuccess || hipDeviceGetAttribute(&cus, hipDeviceAttributeMultiprocessorCount, dev) != hipSuccess) { fprintf(stderr, "kernel_launch: device query failed\n"); grid = -1; return; }
        if (hipFuncSetAttribute((const void*)mega_fwd, hipFuncAttributeMaxDynamicSharedMemorySize, LDS_BYTES) != hipSuccess) { fprintf(stderr, "kernel_launch: hipFuncSetAttribute failed\n"); grid = -1; return; }
        if (hipOccupancyMaxActiveBlocksPerMultiprocessor(&per_cu, (const void*)mega_fwd, NWAVES * 64, LDS_BYTES) != hipSuccess || per_cu < 1) { fprintf(stderr, "kernel_launch: occupancy query reports %d blocks per CU\n", per_cu); (void)hipGetLastError(); if (per_cu < 1) { grid = -1; return; } }
        grid = cus;
    }
    if (grid < 0) return;
    if (hipMemsetAsync((char*)d_ws + WS_CTL, 0, CTL_ZERO_BYTES, stream) != hipSuccess) { fprintf(stderr, "kernel_launch: memset failed\n"); return; }
    Args a{};
    for (int i = 0; i < 24; ++i) a.in[i] = d_in[i];
    a.out = (float*)d_out; a.ws = (unsigned char*)d_ws;
    hipLaunchKernelGGL(mega_fwd, dim3(grid), dim3(NWAVES * 64), LDS_BYTES, stream, a);
    const hipError_t le = hipPeekAtLastError();
    if (le != hipSuccess) fprintf(stderr, "kernel_launch: launch failed: %s\n", hipGetErrorName(le));
}
```
